# Optimizing an MI355X kernel written in HIP

```python
import math
import jax, jax.numpy as jnp
from jax import lax
import numpy as np

D_MODEL = 1024
BATCH = 4
SEQ = 8192
DEPTH = 1

CHUNK = 64
Q_BLOCK = 128
EPS = 1e-6

MLA_HEADS = 8
QK_NOPE_DIM = 64
QK_ROPE_DIM = 32
V_HEAD_DIM = 128
Q_LORA_RANK = 384
KV_LORA_RANK = 256
MLA_WIDTH = MLA_HEADS * V_HEAD_DIM
ROPE_THETA = 10000.0

GMLP_GROUPS = 8
GMLP_GROUP_DIM = 128
GMLP_WIDTH = GMLP_GROUPS * GMLP_GROUP_DIM
SPATIAL_BLOCK = 128

D_MIX = MLA_WIDTH + GMLP_WIDTH

IN_SPLITS = (
    Q_LORA_RANK,
    KV_LORA_RANK,
    QK_ROPE_DIM,
    MLA_WIDTH,
    GMLP_WIDTH,
    GMLP_WIDTH,
    GMLP_WIDTH,
)
D_IN = sum(IN_SPLITS)

kernel_name = "hybrid_gmlp_mla_parallel_heads"


def rms_norm(x, g):
    xf = x.astype(jnp.float32)
    y = xf * lax.rsqrt(jnp.mean(xf * xf, axis=-1, keepdims=True) + EPS)
    return (y * g.astype(jnp.float32)).astype(x.dtype)


def layer_norm(x, g, b):
    xf = x.astype(jnp.float32)
    mu = jnp.mean(xf, axis=-1, keepdims=True)
    var = jnp.mean(jnp.square(xf - mu), axis=-1, keepdims=True)
    y = (xf - mu) * lax.rsqrt(var + EPS)
    return (y * g.astype(jnp.float32) + b.astype(jnp.float32)).astype(x.dtype)


def rope_tables(seq):
    pos = jnp.arange(seq, dtype=jnp.float32)
    inv_freq = ROPE_THETA ** (-jnp.arange(0, QK_ROPE_DIM, 2, dtype=jnp.float32) / QK_ROPE_DIM)
    ang = pos[:, None] * inv_freq[None, :]
    return jnp.cos(ang), jnp.sin(ang)


def apply_rope(x, cos, sin):
    xf = x.astype(jnp.float32)
    x1, x2 = jnp.split(xf, 2, axis=-1)
    out = jnp.concatenate([x1 * cos - x2 * sin, x1 * sin + x2 * cos], axis=-1)
    return out.astype(x.dtype)


def mla_branch(q_lat, kv_lat, k_rope_raw, q_norm_g, w_uq, kv_norm_g, w_ukv):
    b, s, _ = q_lat.shape
    cos, sin = rope_tables(s)
    q = jnp.einsum("bsr,rd->bsd", rms_norm(q_lat, q_norm_g), w_uq)
    q = q.reshape(b, s, MLA_HEADS, QK_NOPE_DIM + QK_ROPE_DIM)
    q_nope, q_rope = q[..., :QK_NOPE_DIM], q[..., QK_NOPE_DIM:]
    q_rope = apply_rope(q_rope, cos[None, :, None, :], sin[None, :, None, :])
    k_rope = apply_rope(k_rope_raw, cos[None], sin[None])
    kv = jnp.einsum("bsr,rd->bsd", rms_norm(kv_lat, kv_norm_g), w_ukv)
    kv = kv.reshape(b, s, MLA_HEADS, QK_NOPE_DIM + V_HEAD_DIM)
    k_nope, v = kv[..., :QK_NOPE_DIM], kv[..., QK_NOPE_DIM:]

    scale = 1.0 / math.sqrt(QK_NOPE_DIM + QK_ROPE_DIM)
    n_blocks = s // Q_BLOCK
    k_chunk = jnp.arange(s) // CHUNK
    qn_blocks = q_nope.reshape(b, n_blocks, Q_BLOCK, MLA_HEADS, QK_NOPE_DIM).transpose(1, 0, 2, 3, 4)
    qr_blocks = q_rope.reshape(b, n_blocks, Q_BLOCK, MLA_HEADS, QK_ROPE_DIM).transpose(1, 0, 2, 3, 4)
    starts = jnp.arange(n_blocks, dtype=jnp.int32) * Q_BLOCK

    def attend(args):
        qn, qr, start = args
        sc = (jnp.einsum("bqhd,bkhd->bhqk", qn, k_nope)
              + jnp.einsum("bqhr,bkr->bhqk", qr, k_rope)).astype(jnp.float32) * scale
        q_chunk = (start + jnp.arange(Q_BLOCK)) // CHUNK
        mask = k_chunk[None, :] <= q_chunk[:, None]
        sc = jnp.where(mask[None, None], sc, jnp.float32(-1e30))
        p = jax.nn.softmax(sc, axis=-1).astype(v.dtype)
        return jnp.einsum("bhqk,bkhd->bqhd", p, v)

    out = lax.map(attend, (qn_blocks, qr_blocks, starts))
    return out.transpose(1, 0, 2, 3, 4).reshape(b, s, MLA_WIDTH)


def gmlp_branch(u, v, ln_g, ln_b, w_spatial, b_spatial):
    b, s, _ = u.shape
    v = layer_norm(v, ln_g, ln_b)
    nc = s // SPATIAL_BLOCK
    v = v.reshape(b, nc, SPATIAL_BLOCK, GMLP_GROUPS, GMLP_GROUP_DIM)
    t_idx = jnp.arange(SPATIAL_BLOCK) // CHUNK
    mask = (t_idx[None, :] <= t_idx[:, None]).astype(w_spatial.dtype)
    ws = w_spatial * mask[None]
    mixed = jnp.einsum("gts,bcsgd->bctgd", ws, v) + b_spatial.T[None, None, :, :, None]
    return u * mixed.reshape(b, s, GMLP_WIDTH)


def setup_inputs(seed: int = 0) -> dict:
    key = jax.random.key(seed)
    ks = jax.random.split(key, 16)
    f32 = jnp.float32

    def normal(k, shape, scale):
        return jax.random.normal(k, shape, f32) * scale

    def gain(k, n):
        return 1.0 + 0.02 * jax.random.normal(k, (n,), f32)

    return {
        "x": jax.random.normal(ks[0], (BATCH, SEQ, D_MODEL), f32),
        "norm_in_g": gain(ks[1], D_MODEL),
        "w_in": normal(ks[2], (D_MODEL, D_IN), D_MODEL ** -0.5),
        "q_norm_g": gain(ks[3], Q_LORA_RANK),
        "w_uq": normal(ks[4], (Q_LORA_RANK, MLA_HEADS * (QK_NOPE_DIM + QK_ROPE_DIM)), Q_LORA_RANK ** -0.5),
        "kv_norm_g": gain(ks[5], KV_LORA_RANK),
        "w_ukv": normal(ks[6], (KV_LORA_RANK, MLA_HEADS * (QK_NOPE_DIM + V_HEAD_DIM)), KV_LORA_RANK ** -0.5),
        "gmlp_ln_g": gain(ks[7], GMLP_WIDTH),
        "gmlp_ln_b": normal(ks[8], (GMLP_WIDTH,), 0.02),
        "w_spatial": normal(ks[9], (GMLP_GROUPS, SPATIAL_BLOCK, SPATIAL_BLOCK), SPATIAL_BLOCK ** -0.5),
        "b_spatial": 1.0 + normal(ks[10], (GMLP_GROUPS, SPATIAL_BLOCK), 0.02),
        "out_norm_mla_g": gain(ks[11], MLA_WIDTH),
        "out_norm_gmlp_g": gain(ks[12], GMLP_WIDTH),
        "w_out": normal(ks[13], (D_MIX, D_MODEL), D_MIX ** -0.5),
        "final_norm_g": gain(ks[14], D_MODEL),
    }


def reference(x, norm_in_g, w_in, q_norm_g, w_uq, kv_norm_g, w_ukv,
              gmlp_ln_g, gmlp_ln_b, w_spatial, b_spatial,
              out_norm_mla_g, out_norm_gmlp_g, w_out, final_norm_g):
    h = x
    bounds = list(np.cumsum(IN_SPLITS)[:-1])
    for _ in range(DEPTH):
        y = rms_norm(h, norm_in_g)
        proj = jnp.einsum("bsd,de->bse", y, w_in)
        q_lat, kv_lat, k_rope, gate_mla, u, v, gate_gmlp = jnp.split(proj, bounds, axis=-1)

        o_mla = mla_branch(q_lat, kv_lat, k_rope, q_norm_g, w_uq, kv_norm_g, w_ukv)
        o_gmlp = gmlp_branch(jax.nn.gelu(u, approximate=False), jax.nn.gelu(v, approximate=False),
                             gmlp_ln_g, gmlp_ln_b, w_spatial, b_spatial)

        o_mla = rms_norm(o_mla, out_norm_mla_g) * jax.nn.silu(gate_mla)
        o_gmlp = rms_norm(o_gmlp, out_norm_gmlp_g) * jax.nn.silu(gate_gmlp)
        mixed = jnp.concatenate([o_mla, o_gmlp], axis=-1)
        h = h + jnp.einsum("bse,ed->bsd", mixed, w_out)
    return rms_norm(h, final_norm_g)
```

```cpp
#include <hip/hip_runtime.h>
#include <hip/hip_cooperative_groups.h>
#include <cstdio>
#include <cstdint>
#include <cmath>
namespace pg8 {
#define PG8_LAS __attribute__((address_space(3)))
typedef unsigned short bf16_t;
typedef short bf16x8 __attribute__((ext_vector_type(8)));
typedef float f32x4 __attribute__((ext_vector_type(4)));
typedef unsigned u32x4 __attribute__((ext_vector_type(4)));
constexpr int BM = 256, BK = 64, HALF = 128, HTB = HALF * BK * 2  , STAGE_BYTES = 8 * HTB, NXCD = 8, WGM = 8;

__host__ __device__ __forceinline__ int lds_byte(int r, int c) { const int st = (r >> 4) * 2 + (c >> 5), rr = r & 15, cc = c & 31, ob = rr * 64 + cc * 2; return st * 1024 + (ob ^ (((ob >> 9) & 1) << 5)); }
__host__ __device__ __forceinline__ void stage_rc(int b, int& R, int& C) { const int st = b / 1024, sb = b % 1024, swz = sb ^ (((sb >> 9) & 1) << 5); R = (st >> 1) * 16 + swz / 64; C = (st & 1) * 32 + (swz % 64) / 2; }
__host__ __device__ __forceinline__ int perm32(int rho) { const int n = rho >> 4, i = rho & 15; return 8 * (i >> 2) + 4 * n + (i & 3); }

struct Unit { int pm, pn; };
struct Gemm { const bf16_t* A; const bf16_t* Bt; int M, N, K; };

struct StaticOrder {
    int nM, nN, nwg, G, c;
    __host__ __device__ void init(int M, int N, int G_, int c_) { nM = M / BM; nN = N / BM; nwg = nM * nN; G = G_; c = c_; }
    __host__ __device__ bool next(int i, Unit& u) const {
        const long L = (long)i * G + c; if (L >= nwg) return false;
        int wgid = (int)L; { const int q = nwg / NXCD, r = nwg % NXCD, xcd = wgid % NXCD, off = wgid / NXCD; wgid = (xcd < r ? xcd * (q + 1) : r * (q + 1) + (xcd - r) * q) + off; }
        const int nig = WGM * nN, gid = wgid / nig, fm = gid * WGM, gsz = (nM - fm) < WGM ? (nM - fm) : WGM;
        u.pm = fm + ((wgid % nig) % gsz); u.pn = (wgid % nig) / gsz; return true;
    }
    __device__ __forceinline__ void a_ready(const Unit&) const {}
    __device__ __forceinline__ void done(const Unit&) const {}
};

__device__ __forceinline__ unsigned cvt_pk_bf16(float lo, float hi) { unsigned r; asm volatile("v_cvt_pk_bf16_f32 %0, %1, %2" : "=v"(r) : "v"(lo), "v"(hi)); return r; }
typedef float f32x2 __attribute__((ext_vector_type(2)));
__device__ __forceinline__ f32x2 gelu_pk(f32x2 v) {
    const f32x2 av = __builtin_elementwise_abs(v), d = av * 0.2316418882f + 1.0f;
    f32x2 t; t.x = __builtin_amdgcn_rcpf(d.x); t.y = __builtin_amdgcn_rcpf(d.y);
    f32x2 q = t * 0.5307027145f + (-0.7265760135f); q = q * t + 0.7107068705f; q = q * t + (-0.142248368f); q = q * t + 0.127414796f; q = q * t;
    const f32x2 s = (v * v) * (-0.72134752044f);
    f32x2 e; e.x = __builtin_amdgcn_exp2f(s.x); e.y = __builtin_amdgcn_exp2f(s.y);
    const f32x2 m = v * (q * e), r = v - m;
    f32x2 o; o.x = v.x < 0.f ? m.x : r.x; o.y = v.y < 0.f ? m.y : r.y; return o;
}

__device__ __forceinline__ float silu_f(float v) { return v * __builtin_amdgcn_rcpf(1.0f + __builtin_amdgcn_exp2f(-1.4426950408889634f * v)); }
__device__ __forceinline__ u32x4 pack8(const f32x4 v0, const f32x4 v1) { u32x4 w; w.x = cvt_pk_bf16(v0[0], v0[1]); w.y = cvt_pk_bf16(v0[2], v0[3]); w.z = cvt_pk_bf16(v1[0], v1[1]); w.w = cvt_pk_bf16(v1[2], v1[3]); return w; }
__device__ __forceinline__ void rope8(f32x4& v0, f32x4& v1, const char* tb_u, unsigned tb_l, int fq) {
    const f32x4* tb = (const f32x4*)(tb_u + tb_l);
    const f32x4 t0 = tb[0], t1 = tb[1], t2 = tb[2], t3 = tb[3];
    const float sg = (fq < 2) ? -1.0f : 1.0f;
    f32x4 o0, o1;
#pragma unroll
    for (int k = 0; k < 4; ++k) { o0[k] = __shfl_xor(v0[k], 32) * sg; o1[k] = __shfl_xor(v1[k], 32) * sg; }
    v0[0] = v0[0] * t0[0] + o0[0] * t0[1]; v0[1] = v0[1] * t0[2] + o0[1] * t0[3];
    v0[2] = v0[2] * t1[0] + o0[2] * t1[1]; v0[3] = v0[3] * t1[2] + o0[3] * t1[3];
    v1[0] = v1[0] * t2[0] + o1[0] * t2[1]; v1[1] = v1[1] * t2[2] + o1[1] * t2[3];
    v1[2] = v1[2] * t3[0] + o1[2] * t3[1]; v1[3] = v1[3] * t3[2] + o1[3] * t3[3];
}

struct EpiProj {
    static constexpr bool PERM = true, AFTER_DRAIN = false, MIDK = false;
    const float* rsx; bf16_t *QLAT, *KVLAT, *KB, *AMIX, *U, *V; const float* rope;
    __device__ __forceinline__ void begin(const Unit&, int) const {}
    __device__ __forceinline__ void operator()(const f32x4 (&acc)[2][2][4][2], const Unit& u, int, int wr, int wc, int fr, int fq) const {
        const int rl = wr * 64 + fr;
        const int rowu = u.pm * BM;
        float rs[2][4];
#pragma unroll
        for (int ai = 0; ai < 2; ++ai)
#pragma unroll
            for (int m = 0; m < 4; ++m) rs[ai][m] = *(const float*)((const char*)(rsx + rowu + ai * HALF + m * 16) + (unsigned)rl * 4u);
#pragma unroll
        for (int bj = 0; bj < 2; ++bj) {
            const int cg = u.pn * BM + bj * HALF + wc * 32;
            int kind = 0, ld = 0, cofs = 0; bf16_t* base = nullptr;
            if (cg < 384) { kind = 0; base = QLAT; ld = 384; cofs = cg; }
            else if (cg < 640) { kind = 0; base = KVLAT; ld = 256; cofs = cg - 384; }
            else if (cg < 672) { kind = 3; }
            else if (cg < 768) { kind = 4; }
            else if (cg < 1792) { kind = 1; base = AMIX; ld = 2048; cofs = cg - 768; }
            else if (cg < 2816) { kind = 2; base = U; ld = 1024; cofs = cg - 1792; }
            else if (cg < 3840) { kind = 2; base = V; ld = 1024; cofs = cg - 2816; }
            else { kind = 1; base = AMIX; ld = 2048; cofs = cg - 3840 + 1024; }
            if (kind == 4) continue;
            if (kind == 3) {
                const unsigned kl = (unsigned)(rl * 768 + 64 + 8 * fq) * 2u, tl = (unsigned)(rl * 16 + 8 * (fq & 1)) * 8u;
#pragma unroll
                for (int ai = 0; ai < 2; ++ai)
#pragma unroll
                    for (int m = 0; m < 4; ++m) {
                        const int rb = rowu + ai * HALF + m * 16;
                        f32x4 v0 = acc[ai][bj][m][0] * rs[ai][m], v1 = acc[ai][bj][m][1] * rs[ai][m];
                        rope8(v0, v1, (const char*)(rope + (size_t)(rb & 8191) * 32), tl, fq);
                        const u32x4 w = pack8(v0, v1);
                        char* kp = (char*)(KB + (size_t)rb * 768) + kl;
#pragma unroll
                        for (int h = 0; h < 8; ++h) *(u32x4*)(kp + h * 192) = w;
                        asm volatile("" ::: "memory");
                    }
                continue;
            }
            const unsigned ll = (unsigned)(rl * ld + 8 * fq) * 2u;
#pragma unroll
            for (int ai = 0; ai < 2; ++ai)
#pragma unroll
                for (int m = 0; m < 4; ++m) {
                    const int rb = rowu + ai * HALF + m * 16;
                    f32x4 v0 = acc[ai][bj][m][0] * rs[ai][m], v1 = acc[ai][bj][m][1] * rs[ai][m];
                    if (kind == 1) {
#pragma unroll
                        for (int k = 0; k < 4; ++k) { v0[k] = silu_f(v0[k]); v1[k] = silu_f(v1[k]); }
                    } else if (kind == 2) {
                        const f32x2 a = gelu_pk((f32x2){v0[0], v0[1]}), b = gelu_pk((f32x2){v0[2], v0[3]}), c = gelu_pk((f32x2){v1[0], v1[1]}), d = gelu_pk((f32x2){v1[2], v1[3]});
                        v0 = (f32x4){a.x, a.y, b.x, b.y}; v1 = (f32x4){c.x, c.y, d.x, d.y};
                    }
                    *(u32x4*)((char*)(base + (size_t)rb * ld + cofs) + ll) = pack8(v0, v1);
                }
        }
    }
};

struct EpiQ {
    static constexpr bool PERM = true, AFTER_DRAIN = false, MIDK = false;
    const float* rsq; bf16_t* Q; const float* rope;
    __device__ __forceinline__ void begin(const Unit&, int) const {}
    __device__ __forceinline__ void operator()(const f32x4 (&acc)[2][2][4][2], const Unit& u, int, int wr, int wc, int fr, int fq) const {
        const int rl = wr * 64 + fr, rowu = u.pm * BM;
        const unsigned ql = (unsigned)(rl * 768 + 8 * fq) * 2u, tl = (unsigned)(rl * 16 + 8 * (fq & 1)) * 8u;
        float rs[2][4];
#pragma unroll
        for (int ai = 0; ai < 2; ++ai)
#pragma unroll
            for (int m = 0; m < 4; ++m) rs[ai][m] = *(const float*)((const char*)(rsq + rowu + ai * HALF + m * 16) + (unsigned)rl * 4u);
#pragma unroll
        for (int bj = 0; bj < 2; ++bj) {
            const int cg = u.pn * BM + bj * HALF + wc * 32; const int gi = cg >> 5; const bool isrope = (gi % 3) == 2;
#pragma unroll
            for (int ai = 0; ai < 2; ++ai)
#pragma unroll
                for (int m = 0; m < 4; ++m) {
                    const int rb = rowu + ai * HALF + m * 16;
                    f32x4 v0 = acc[ai][bj][m][0] * rs[ai][m], v1 = acc[ai][bj][m][1] * rs[ai][m];
                    if (isrope) rope8(v0, v1, (const char*)(rope + (size_t)(rb & 8191) * 32), tl, fq);
                    *(u32x4*)((char*)(Q + (size_t)rb * 768 + cg) + ql) = pack8(v0, v1);
                    if (isrope) asm volatile("" ::: "memory");
                }
        }
    }
};

struct EpiKV {
    static constexpr bool PERM = true, AFTER_DRAIN = false, MIDK = false;
    const float* rskv; bf16_t *KB, *VV;
    __device__ __forceinline__ void begin(const Unit&, int) const {}
    __device__ __forceinline__ void operator()(const f32x4 (&acc)[2][2][4][2], const Unit& u, int, int wr, int wc, int fr, int fq) const {
        const int rl = wr * 64 + fr, rowu = u.pm * BM;
        float rs[2][4];
#pragma unroll
        for (int ai = 0; ai < 2; ++ai)
#pragma unroll
            for (int m = 0; m < 4; ++m) rs[ai][m] = *(const float*)((const char*)(rskv + rowu + ai * HALF + m * 16) + (unsigned)rl * 4u);
#pragma unroll
        for (int bj = 0; bj < 2; ++bj) {
            const int cg = u.pn * BM + bj * HALF + wc * 32; const int gi = cg >> 5, h = gi / 6, jg = gi - 6 * h;
            bf16_t* base; int ld;
            if (jg < 2) { base = KB + h * 96 + jg * 32; ld = 768; } else { base = VV + h * 128 + (jg - 2) * 32; ld = 1024; }
            const unsigned ll = (unsigned)(rl * ld + 8 * fq) * 2u;
#pragma unroll
            for (int ai = 0; ai < 2; ++ai)
#pragma unroll
                for (int m = 0; m < 4; ++m) {
                    const int rb = rowu + ai * HALF + m * 16;
                    const f32x4 v0 = acc[ai][bj][m][0] * rs[ai][m], v1 = acc[ai][bj][m][1] * rs[ai][m];
                    *(u32x4*)((char*)(base + (size_t)rb * ld) + ll) = pack8(v0, v1);
                }
        }
    }
};

struct EpiOut {
    static constexpr bool PERM = false, AFTER_DRAIN = false, MIDK = true;
    const float* x; float* out; const float* ssqm; const float* ssqg; float* hsq; PG8_LAS float* tab;
    __device__ __forceinline__ void begin(const Unit& u, int ui) const {
        const int tid = threadIdx.x;
        if (tid < 256) {
            const int row = u.pm * BM + tid;
            const f32x4 a = *(const f32x4*)(ssqm + (size_t)row * 8), b = *(const f32x4*)(ssqm + (size_t)row * 8 + 4);
            const float sm = ((a[0] + a[1]) + (a[2] + a[3])) + ((b[0] + b[1]) + (b[2] + b[3]));
            const float sg = ssqg[(size_t)row * 2] + ssqg[(size_t)row * 2 + 1];
            const float rm = __builtin_amdgcn_rsqf(sm * (1.0f / 1024.0f) + 1e-6f), rg = __builtin_amdgcn_rsqf(sg * (1.0f / 1024.0f) + 1e-6f);
            tab[(ui & 1) * 512 + tid * 2] = rm / rg; tab[(ui & 1) * 512 + tid * 2 + 1] = rg;
        }
    }
    __device__ __forceinline__ void mid(f32x4 (&acc)[2][2][4][2], const Unit&, int ui, int wr, int, int fr, int) const {
#pragma unroll
        for (int ai = 0; ai < 2; ++ai)
#pragma unroll
            for (int m = 0; m < 4; ++m) {
                const float f = tab[(ui & 1) * 512 + (ai * HALF + wr * 64 + m * 16 + fr) * 2];
#pragma unroll
                for (int bj = 0; bj < 2; ++bj)
#pragma unroll
                    for (int n = 0; n < 2; ++n) acc[ai][bj][m][n] *= f;
            }
    }
    __device__ __forceinline__ void operator()(const f32x4 (&acc)[2][2][4][2], const Unit& u, int ui, int wr, int wc, int fr, int fq) const {
        const int rl = wr * 64 + fr, rowu = u.pm * BM;
        const unsigned ol = (unsigned)(rl * 1024 + wc * 32 + 4 * fq) * 4u;
#pragma unroll
        for (int ai = 0; ai < 2; ++ai)
#pragma unroll
            for (int m = 0; m < 4; ++m) {
                const int r = ai * HALF + m * 16 + rl; const int rb = rowu + ai * HALF + m * 16;
                const float g = tab[(ui & 1) * 512 + r * 2 + 1];
                float ss = 0.f;
#pragma unroll
                for (int bj = 0; bj < 2; ++bj)
#pragma unroll
                    for (int n = 0; n < 2; ++n) {
                        const size_t offu = ((size_t)rb * 1024 + u.pn * BM + bj * HALF + n * 16) * 4;
                        const f32x4 xv = *(const f32x4*)((const char*)x + offu + ol);
                        const f32x4 hv = xv + acc[ai][bj][m][n] * g;
                        ss += (hv[0] * hv[0] + hv[1] * hv[1]) + (hv[2] * hv[2] + hv[3] * hv[3]);
                        *(f32x4*)((char*)out + offu + ol) = hv;
                    }
                ss += __shfl_xor(ss, 16); ss += __shfl_xor(ss, 32);
                if (fq == 0) *(float*)((char*)(hsq + (size_t)rb * 16 + u.pn * 4 + wc) + (unsigned)rl * 64u) = ss;
            }
    }
};

template <class Epi, class Sched, bool ALIGN_EPI = false, bool SP2 = false>
__device__ __forceinline__ void gemm_phase(PG8_LAS unsigned char* lds, const Gemm g, const Sched& S, const Epi& E) {
    const int tid = threadIdx.x, wid = __builtin_amdgcn_readfirstlane(tid >> 6), lane = tid & 63, wr = wid >> 2, wc = wid & 3, fr = lane & 15, fq = lane >> 4;
    const int K = g.K, nt = K / BK;
    unsigned voffA[2], voffB[2];
#pragma unroll
    for (int i = 0; i < 2; ++i) { int R, C; stage_rc(tid * 16 + i * 8192, R, C); const int Rb = Epi::PERM ? ((R & ~31) + perm32(R & 31)) : R;
        voffA[i] = (unsigned)(R * K + C) * 2u; voffB[i] = (unsigned)(Rb * K + C) * 2u; }
    const size_t kstep = (size_t)(BK * 2);
    const size_t hstep = (size_t)HALF * K * 2;
    const size_t tstep = 2 * hstep;
    const unsigned ldsw = (unsigned)wid * 1024u;
    const int aoff = lds_byte(wr * 64 + fr, fq * 8), boff = lds_byte(wc * 32 + fr, fq * 8);
#define PG8_SA(b, h) (((b) * 2 + (h)) * HTB)
#define PG8_SB(b, h) ((4 + (b) * 2 + (h)) * HTB)
#define PG8_STAGE(bufoff, gbase, voff) do { _Pragma("unroll") for (int _i = 0; _i < 2; ++_i) \
        __builtin_amdgcn_global_load_lds((const unsigned*)((const char*)(gbase) + (voff)[_i]), (PG8_LAS unsigned*)(lds + (bufoff) + ldsw + _i * 8192), 16, 0, 0); } while (0)
#define PG8_LDA(dst, b, h) do { _Pragma("unroll") for (int m = 0; m < 4; ++m) _Pragma("unroll") for (int k = 0; k < 2; ++k) dst[m][k] = *(const PG8_LAS bf16x8*)(lds + PG8_SA(b, h) + aoff + m * 2048 + k * 1024); } while (0)
#define PG8_LDB(dst, b, h) do { _Pragma("unroll") for (int n = 0; n < 2; ++n) _Pragma("unroll") for (int k = 0; k < 2; ++k) dst[n][k] = *(const PG8_LAS bf16x8*)(lds + PG8_SB(b, h) + boff + n * 2048 + k * 1024); } while (0)
#define PG8_MMA(ai, bj, At, Bt) do { __builtin_amdgcn_s_setprio(1); _Pragma("unroll") for (int m = 0; m < 4; ++m) _Pragma("unroll") for (int n = 0; n < 2; ++n) _Pragma("unroll") for (int k = 0; k < 2; ++k) \
        acc[ai][bj][m][n] = __builtin_amdgcn_mfma_f32_16x16x32_bf16(Bt[n][k], At[m][k], acc[ai][bj][m][n], 0, 0, 0); __builtin_amdgcn_s_setprio(0); } while (0)
#define PG8_WAIT_V(n) asm volatile("s_waitcnt vmcnt(" #n ")" ::: "memory")
#define PG8_WAIT_L(n) asm volatile("s_waitcnt lgkmcnt(" #n ")" ::: "memory")
#define PG8_BAR __builtin_amdgcn_s_barrier()
#define PG8_SCHED __builtin_amdgcn_sched_barrier(0)
    Unit cur, nxt; int ui = 0;
    if (!S.next(0, cur)) return;
    E.begin(cur, 0);
    f32x4 acc[2][2][4][2];
#pragma unroll
    for (int a = 0; a < 2; ++a)
#pragma unroll
        for (int b = 0; b < 2; ++b)
#pragma unroll
            for (int m = 0; m < 4; ++m)
#pragma unroll
                for (int n = 0; n < 2; ++n) acc[a][b][m][n] = (f32x4){0.f, 0.f, 0.f, 0.f};
    bf16x8 At[4][2], B0[2][2], B1[2][2];
    const char* cA = (const char*)g.A + (size_t)cur.pm * tstep; const char* cB = (const char*)g.Bt + (size_t)cur.pn * tstep;
    S.a_ready(cur);
    if constexpr (SP2) {
        PG8_STAGE(PG8_SB(0, 0), cB, voffB); PG8_STAGE(PG8_SB(0, 1), cB + hstep, voffB); PG8_STAGE(PG8_SA(0, 0), cA, voffA); PG8_STAGE(PG8_SA(0, 1), cA + hstep, voffA);
        if (wr == 1) PG8_BAR;
        PG8_WAIT_V(2); PG8_BAR;
        PG8_STAGE(PG8_SB(1, 0), cB + kstep, voffB); PG8_STAGE(PG8_SA(1, 0), cA + kstep, voffA); PG8_STAGE(PG8_SB(1, 1), cB + hstep + kstep, voffB);
        PG8_WAIT_V(6); PG8_BAR;
    } else {
        PG8_STAGE(PG8_SB(0, 0), cB, voffB); PG8_STAGE(PG8_SA(0, 0), cA, voffA); PG8_STAGE(PG8_SB(0, 1), cB + hstep, voffB); PG8_STAGE(PG8_SA(0, 1), cA + hstep, voffA);
        if (wr == 1) PG8_BAR;
        PG8_WAIT_V(4); PG8_BAR;
        PG8_STAGE(PG8_SB(1, 0), cB + kstep, voffB); PG8_STAGE(PG8_SA(1, 0), cA + kstep, voffA); PG8_STAGE(PG8_SB(1, 1), cB + hstep + kstep, voffB);
        PG8_WAIT_V(6); PG8_BAR;
    }
    for (;;) {
        const bool has_next = S.next(ui + 1, nxt);
        const char* nA = has_next ? (const char*)g.A + (size_t)nxt.pm * tstep : cA; const char* nB = has_next ? (const char*)g.Bt + (size_t)nxt.pn * tstep : cB;
        for (int t = 0; t < nt; t += 2) {
            const bool last = (t == nt - 2);
            if constexpr (Epi::MIDK) { if (t == (nt >> 1)) E.mid(acc, cur, ui, wr, wc, fr, fq); }
            const char* a1 = cA + (size_t)(t + 1) * kstep;
            const char* a2 = last ? nA : cA + (size_t)(t + 2) * kstep; const char* b2 = last ? nB : cB + (size_t)(t + 2) * kstep;
            const char* a3 = a2 + kstep; const char* b3 = b2 + kstep;
            if (last && has_next) S.a_ready(nxt);
            if constexpr (SP2) {
            PG8_LDB(B0, 0, 0); PG8_LDB(B1, 0, 1); PG8_SCHED; PG8_LDA(At, 0, 0); PG8_STAGE(PG8_SA(1, 1), a1 + hstep, voffA);
            PG8_WAIT_V(8); PG8_WAIT_L(0); PG8_BAR; PG8_MMA(0, 0, At, B0); PG8_MMA(0, 1, At, B1); PG8_BAR; PG8_SCHED;
            PG8_LDA(At, 0, 1); PG8_STAGE(PG8_SB(0, 0), b2, voffB); PG8_STAGE(PG8_SB(0, 1), b2 + hstep, voffB); PG8_STAGE(PG8_SA(0, 0), a2, voffA);
            PG8_WAIT_V(8); PG8_WAIT_L(0); PG8_BAR; PG8_MMA(1, 0, At, B0); PG8_MMA(1, 1, At, B1); PG8_BAR; PG8_SCHED;
            PG8_LDB(B0, 1, 0); PG8_LDB(B1, 1, 1); PG8_SCHED; PG8_LDA(At, 1, 0); PG8_STAGE(PG8_SA(0, 1), a2 + hstep, voffA);
            PG8_WAIT_V(8); PG8_WAIT_L(0); PG8_BAR; PG8_MMA(0, 0, At, B0); PG8_MMA(0, 1, At, B1); PG8_BAR; PG8_SCHED;
            PG8_LDA(At, 1, 1); PG8_STAGE(PG8_SB(1, 0), b3, voffB); PG8_STAGE(PG8_SB(1, 1), b3 + hstep, voffB); PG8_STAGE(PG8_SA(1, 0), a3, voffA);
            PG8_WAIT_V(8); PG8_WAIT_L(0); PG8_BAR; PG8_MMA(1, 0, At, B0); PG8_MMA(1, 1, At, B1); PG8_BAR; PG8_SCHED;
            } else {
            PG8_LDB(B0, 0, 0); PG8_SCHED; PG8_LDA(At, 0, 0); PG8_STAGE(PG8_SA(1, 1), a1 + hstep, voffA);
            PG8_WAIT_L(8); PG8_BAR; PG8_WAIT_L(0); PG8_MMA(0, 0, At, B0); PG8_BAR; PG8_SCHED;
            PG8_LDB(B1, 0, 1); PG8_STAGE(PG8_SB(0, 0), b2, voffB);
            PG8_BAR; PG8_WAIT_L(0); PG8_MMA(0, 1, At, B1); PG8_BAR;
            PG8_LDA(At, 0, 1); PG8_STAGE(PG8_SA(0, 0), a2, voffA);
            PG8_BAR; PG8_WAIT_L(0); PG8_MMA(1, 0, At, B0); PG8_BAR; PG8_SCHED;
            PG8_STAGE(PG8_SB(0, 1), b2 + hstep, voffB);
            PG8_WAIT_V(6); PG8_BAR; PG8_MMA(1, 1, At, B1); PG8_BAR;
            PG8_LDB(B0, 1, 0); PG8_SCHED; PG8_LDA(At, 1, 0); PG8_STAGE(PG8_SA(0, 1), a2 + hstep, voffA);
            PG8_WAIT_L(8); PG8_BAR; PG8_WAIT_L(0); PG8_MMA(0, 0, At, B0); PG8_BAR; PG8_SCHED;
            PG8_LDB(B1, 1, 1); PG8_STAGE(PG8_SB(1, 0), b3, voffB);
            PG8_BAR; PG8_WAIT_L(0); PG8_MMA(0, 1, At, B1); PG8_BAR;
            PG8_LDA(At, 1, 1); PG8_STAGE(PG8_SA(1, 0), a3, voffA);
            PG8_BAR; PG8_WAIT_L(0); PG8_MMA(1, 0, At, B0); PG8_BAR; PG8_SCHED;
            PG8_STAGE(PG8_SB(1, 1), b3 + hstep, voffB);
            PG8_WAIT_V(6); PG8_BAR; PG8_MMA(1, 1, At, B1); PG8_BAR;
            }
        }
        if constexpr (ALIGN_EPI) { if (wr == 0) PG8_BAR; }
        if constexpr (!Epi::AFTER_DRAIN) { E(acc, cur, ui, wr, wc, fr, fq); S.done(cur); }
        if (!has_next) break;
#pragma unroll
        for (int a = 0; a < 2; ++a)
#pragma unroll
            for (int b = 0; b < 2; ++b)
#pragma unroll
                for (int m = 0; m < 4; ++m)
#pragma unroll
                    for (int n = 0; n < 2; ++n) acc[a][b][m][n] = (f32x4){0.f, 0.f, 0.f, 0.f};
        cur = nxt; cA = nA; cB = nB; ++ui; E.begin(cur, ui);
        if constexpr (ALIGN_EPI) { if (wr == 1) PG8_BAR; }
    }
    PG8_WAIT_V(0);
    if constexpr (!ALIGN_EPI) { if (wr == 0) PG8_BAR; }
    PG8_BAR;
    if constexpr (Epi::AFTER_DRAIN) { E.fused(acc, cur, wr, wc, fr, fq, lds, wid, lane); S.done(cur); }
#undef PG8_SA
#undef PG8_SB
#undef PG8_STAGE
#undef PG8_LDA
#undef PG8_LDB
#undef PG8_MMA
#undef PG8_WAIT_V
#undef PG8_WAIT_L
#undef PG8_BAR
#undef PG8_SCHED
}
}
namespace att {
typedef unsigned short bf16;
using bf16x8 = __attribute__((ext_vector_type(8))) short;
using s16x4  = __attribute__((ext_vector_type(4))) short;
using f32x16 = __attribute__((ext_vector_type(16))) float;
using f32x4  = __attribute__((ext_vector_type(4))) float;
using u32x4  = __attribute__((ext_vector_type(4))) unsigned;
constexpr int NW = 8, QBLK = 32, KVBLK = 64;
constexpr int LDQ = 768, LDK = 768, LDV = 1024, LDA = 2048;
constexpr float SCALE = 0.10206207261596577f;
constexpr float THR = 8.f;
#ifndef ATT_SDEPTH
#define ATT_SDEPTH 2
#endif
constexpr int SDEPTH = ATT_SDEPTH;
constexpr int SHM_V = KVBLK * 128 * 2, SHM_K = KVBLK * 128 * 2, SHM_ATTN = 2 * SHM_V + 2 * SHM_K + NW * 64 * 4;
#define KSWZ(row, colB) ((row) * 256 + ((colB) ^ (((row) & 7) << 4)))
#define SBAR() __builtin_amdgcn_sched_barrier(0)
__device__ __forceinline__ int crow(int r, int hi) { return (r & 3) + 8 * (r >> 2) + 4 * hi; }
__device__ __forceinline__ unsigned cvtpk(float lo, float hi) { unsigned r; asm volatile("v_cvt_pk_bf16_f32 %0, %1, %2" : "=v"(r) : "v"(lo), "v"(hi)); return r; }
__device__ __forceinline__ float bf2f(bf16 v) { return __uint_as_float((unsigned)v << 16); }
__device__ __forceinline__ bf16 f2bf(float f) { return (bf16)(cvtpk(f, 0.f) & 0xffffu); }

__device__ __forceinline__ void partialSM(f32x16& p0, f32x16& p1, float& m_reg, float& mn, float& alpha) {
  constexpr float C = SCALE * 1.4426950408889634f;
  float pmax = p0[0]; for (int r = 1; r < 16; ++r) pmax = fmaxf(pmax, p0[r]); for (int r = 0; r < 16; ++r) pmax = fmaxf(pmax, p1[r]);
  { auto rr = __builtin_amdgcn_permlane32_swap(__float_as_uint(pmax), __float_as_uint(pmax), false, false);
    pmax = fmaxf(__uint_as_float(rr[0]), __uint_as_float(rr[1])); }
  if (__builtin_expect(__all(pmax - m_reg <= THR / SCALE), 1)) { mn = m_reg; alpha = 1.f; }
  else { mn = fmaxf(m_reg, pmax); alpha = __builtin_amdgcn_exp2f((m_reg - mn) * C); m_reg = mn; }
  float mnC = -mn * C;
  for (int r = 0; r < 16; ++r) p0[r] = fmaf(p0[r], C, mnC); for (int r = 0; r < 16; ++r) p1[r] = fmaf(p1[r], C, mnC);
  for (int r = 0; r < 16; ++r) p0[r] = __builtin_amdgcn_exp2f(p0[r]);
}
__device__ __forceinline__ void finishSM(f32x16& p0, f32x16& p1, float alpha, float& l_reg, bf16x8& pa0, bf16x8& pa1, bf16x8& pa2, bf16x8& pa3) {
  for (int r = 0; r < 16; ++r) p1[r] = __builtin_amdgcn_exp2f(p1[r]);
  float ps = 0; for (int r = 0; r < 16; ++r) ps += p0[r]; for (int r = 0; r < 16; ++r) ps += p1[r];
  { auto rr = __builtin_amdgcn_permlane32_swap(__float_as_uint(ps), __float_as_uint(ps), false, false);
    ps = __uint_as_float(rr[0]) + __uint_as_float(rr[1]); }
  l_reg = l_reg * alpha + ps;
#define PK4(P, BASE, OUT) do { unsigned a0 = cvtpk(P[BASE + 0], P[BASE + 1]), a1 = cvtpk(P[BASE + 2], P[BASE + 3]);   \
    unsigned b0 = cvtpk(P[BASE + 4], P[BASE + 5]), b1 = cvtpk(P[BASE + 6], P[BASE + 7]);                              \
    auto r0 = __builtin_amdgcn_permlane32_swap(a0, b0, false, false); auto r1 = __builtin_amdgcn_permlane32_swap(a1, b1, false, false); \
    u32x4 w = {r0[0], r1[0], r0[1], r1[1]}; OUT = *reinterpret_cast<bf16x8*>(&w); } while (0)
  PK4(p0, 0, pa0); PK4(p0, 8, pa1); PK4(p1, 0, pa2); PK4(p1, 8, pa3);
#undef PK4
}
__device__ __forceinline__ void qkt(f32x16& p0, f32x16& p1, const bf16* Ks, const bf16x8* qr, int r32, int hi) {
  p0 = f32x16{}; p1 = f32x16{};
#pragma unroll
  for (int d0 = 0; d0 < 6; ++d0) { int cb = (d0 * 16 + hi * 8) * 2;
    bf16x8 b0 = *reinterpret_cast<const bf16x8*>((const char*)Ks + KSWZ(r32, cb));
    bf16x8 b1 = *reinterpret_cast<const bf16x8*>((const char*)Ks + KSWZ(32 + r32, cb));
    p0 = __builtin_amdgcn_mfma_f32_32x32x16_bf16(b0, qr[d0], p0, 0, 0, 0);
    p1 = __builtin_amdgcn_mfma_f32_32x32x16_bf16(b1, qr[d0], p1, 0, 0, 0); }
}
__device__ __forceinline__ int v_st(int k, int c) { const int kk = (k & ~0xC) | ((k & 4) << 1) | ((k & 8) >> 1); return ((kk >> 3) * 4 + (c >> 5)) * 512 + ((kk & 7) * 32 + (c & 31)) * 2; }
__device__ __forceinline__ int v_rd_base(int lane) { return ((lane & 3) << 3) | (((lane >> 2) & 3) << 6) | (((lane >> 4) & 1) << 5) | (((lane >> 5) & 1) << 8); }
constexpr int v_rd_off(int d0, int ks, int half) { return d0 * 512 + ks * 4096 + half * 2048; }
template <int OFF> __device__ __forceinline__ s16x4 tr_read(int vb) {
  s16x4 r; asm volatile("ds_read_b64_tr_b16 %0, %1 offset:%2" : "=&v"(r) : "v"(vb), "i"(OFF) : "memory"); return r;
}
template <int D0> __device__ __forceinline__ void pv_one(f32x16& od, int vb, bf16x8 pa0, bf16x8 pa1, bf16x8 pa2, bf16x8 pa3) {
  const s16x4 l0 = tr_read<v_rd_off(D0, 0, 0)>(vb), h0 = tr_read<v_rd_off(D0, 0, 1)>(vb), l1 = tr_read<v_rd_off(D0, 1, 0)>(vb), h1 = tr_read<v_rd_off(D0, 1, 1)>(vb);
  const s16x4 l2 = tr_read<v_rd_off(D0, 2, 0)>(vb), h2 = tr_read<v_rd_off(D0, 2, 1)>(vb), l3 = tr_read<v_rd_off(D0, 3, 0)>(vb), h3 = tr_read<v_rd_off(D0, 3, 1)>(vb);
  asm volatile("s_waitcnt lgkmcnt(0)" ::: "memory"); SBAR();
#define PK(L, H) (bf16x8){L[0], L[1], L[2], L[3], H[0], H[1], H[2], H[3]}
  od = __builtin_amdgcn_mfma_f32_32x32x16_bf16(pa0, PK(l0, h0), od, 0, 0, 0);
  od = __builtin_amdgcn_mfma_f32_32x32x16_bf16(pa1, PK(l1, h1), od, 0, 0, 0);
  od = __builtin_amdgcn_mfma_f32_32x32x16_bf16(pa2, PK(l2, h2), od, 0, 0, 0);
  od = __builtin_amdgcn_mfma_f32_32x32x16_bf16(pa3, PK(l3, h3), od, 0, 0, 0);
#undef PK
}
__device__ __forceinline__ void pv_d0(f32x16* o, int vb, bf16x8 pa0, bf16x8 pa1, bf16x8 pa2, bf16x8 pa3) {
  pv_one<0>(o[0], vb, pa0, pa1, pa2, pa3); pv_one<1>(o[1], vb, pa0, pa1, pa2, pa3); pv_one<2>(o[2], vb, pa0, pa1, pa2, pa3); pv_one<3>(o[3], vb, pa0, pa1, pa2, pa3);
}

__device__ __forceinline__ void attn_unit(const bf16* __restrict__ Qb, const bf16* __restrict__ Kh, const bf16* __restrict__ Vh,
                                          bf16* Ab, float* ssq, int NT, char* lds) {
  const int tid = threadIdx.x, wid = tid >> 6, lane = tid & 63, r32 = lane & 31, hi = lane >> 5;
  const int wlim = NT - 4 + (wid >> 1);
  bf16* V_lds = (bf16*)lds; bf16* K_lds = (bf16*)(lds + 2 * SHM_V);
  float* ws = (float*)(lds + 2 * SHM_V + 2 * SHM_K) + wid * 64; float* li_l = ws; float* al_l = ws + 32;
  float m_reg = -1e30f, l_reg = 0; f32x16 o[4] = {}; bf16x8 qr[6];
  const bf16* Qw = Qb + (long)(wid * QBLK + r32) * LDQ + hi * 8;
#pragma unroll
  for (int d0 = 0; d0 < 6; ++d0) qr[d0] = *reinterpret_cast<const bf16x8*>(Qw + d0 * 16);
  const int sr = tid >> 4, sc = (tid & 15) * 8, vst0 = v_st(sr, sc), vst1 = v_st(32 + sr, sc);
  const int sck = sc < 96 ? sc : sc - 32;
  const int vb0 = (int)(uintptr_t)V_lds + v_rd_base(lane);
  struct { bf16x8 vs0, vs1, ks0, ks1; } sr_[SDEPTH];
  const unsigned kofs = (unsigned)(sr * LDK + sck) * 2u, vofs = (unsigned)(sr * LDV + sc) * 2u;
#define SLOAD(i, k0) do { const char* kb_ = (const char*)Kh + (size_t)(k0) * (LDK * 2); const char* vb_ = (const char*)Vh + (size_t)(k0) * (LDV * 2); \
    sr_[i].vs0 = *(const bf16x8*)(vb_ + vofs); sr_[i].vs1 = *(const bf16x8*)(vb_ + 32 * LDV * 2 + vofs); \
    sr_[i].ks0 = *(const bf16x8*)(kb_ + kofs); sr_[i].ks1 = *(const bf16x8*)(kb_ + 32 * LDK * 2 + kofs); } while (0)
#define SWRITE(b, i) do { *(bf16x8*)((char*)V_lds + (b) * SHM_V + vst0) = sr_[i].vs0;          \
    *(bf16x8*)((char*)V_lds + (b) * SHM_V + vst1) = sr_[i].vs1; int kc = sc * 2;               \
    *(bf16x8*)((char*)K_lds + (b) * SHM_K + KSWZ(sr, kc)) = sr_[i].ks0;                       \
    *(bf16x8*)((char*)K_lds + (b) * SHM_K + KSWZ(32 + sr, kc)) = sr_[i].ks1; } while (0)
#define SWAIT() do { if constexpr (SDEPTH == 2) asm volatile("s_waitcnt vmcnt(4)" ::: "memory"); else asm volatile("s_waitcnt vmcnt(0)" ::: "memory"); } while (0)
#define RESC(a) do { if (__any((a) < 1.f)) { if (hi == 0) al_l[r32] = (a); asm volatile("s_waitcnt lgkmcnt(0)" ::: "memory"); \
    for (int d = 0; d < 4; ++d) for (int r = 0; r < 16; ++r) o[d][r] *= al_l[crow(r, hi)]; } } while (0)
#ifdef EXP_NOMASK
#define TMASK(P0,P1,t) do{}while(0)
#else
#define TMASK(P0, P1, t) do { if ((t) > wlim) { for (int r = 0; r < 16; ++r) { P0[r] = -1e30f; P1[r] = -1e30f; } } } while (0)
#endif
  f32x16 pA0, pA1, pB0, pB1; float mnA, mnB, alA, alB; bf16x8 pa0, pa1, pa2, pa3;
  constexpr int SE = 0, SO = SDEPTH - 1;
  SLOAD(SE, 0); asm volatile("s_waitcnt vmcnt(0)" ::: "memory"); SWRITE(0, SE); __syncthreads();
  qkt(pA0, pA1, K_lds, qr, r32, hi); partialSM(pA0, pA1, m_reg, mnA, alA);
  SLOAD(SO, KVBLK); if constexpr (SDEPTH == 2) { if (2 < NT) SLOAD(SE, 2 * KVBLK); }
  SWAIT(); SWRITE(1, SO); __syncthreads();
  for (int j = 1; j + 1 < NT; j += 2) {
    SBAR(); qkt(pB0, pB1, (bf16*)((char*)K_lds + SHM_K), qr, r32, hi);
    finishSM(pA0, pA1, alA, l_reg, pa0, pa1, pa2, pa3); SBAR();
    SLOAD(SO, (j + SDEPTH) * KVBLK); SBAR();
    pv_d0(o, vb0, pa0, pa1, pa2, pa3); TMASK(pB0, pB1, j); partialSM(pB0, pB1, m_reg, mnB, alB);
    __syncthreads(); SWAIT(); SWRITE(0, SE);
    RESC(alB); __syncthreads();
    SBAR(); qkt(pA0, pA1, K_lds, qr, r32, hi);
    finishSM(pB0, pB1, alB, l_reg, pa0, pa1, pa2, pa3); SBAR();
    if (SDEPTH == 1 || j + 3 < NT) SLOAD(SE, (j + 1 + SDEPTH) * KVBLK); SBAR();
    pv_d0(o, vb0 + (int)SHM_V, pa0, pa1, pa2, pa3); TMASK(pA0, pA1, j + 1); partialSM(pA0, pA1, m_reg, mnA, alA);
    __syncthreads(); SWAIT(); SWRITE(1, SO);
    RESC(alA); __syncthreads();
  }
  SBAR(); qkt(pB0, pB1, (bf16*)((char*)K_lds + SHM_K), qr, r32, hi);
  finishSM(pA0, pA1, alA, l_reg, pa0, pa1, pa2, pa3); SBAR();
  pv_d0(o, vb0, pa0, pa1, pa2, pa3); TMASK(pB0, pB1, NT - 1); partialSM(pB0, pB1, m_reg, mnB, alB);
  __syncthreads(); RESC(alB);
  finishSM(pB0, pB1, alB, l_reg, pa0, pa1, pa2, pa3); SBAR();
  pv_d0(o, vb0 + (int)SHM_V, pa0, pa1, pa2, pa3);
  if (hi == 0) li_l[r32] = l_reg; asm volatile("s_waitcnt lgkmcnt(0)" ::: "memory");
  bf16* stg = (bf16*)(lds + SHM_ATTN + wid * 8704);
  {
    bf16* sp = stg + (4 * hi) * 136 + r32;
#pragma unroll
    for (int r = 0; r < 16; ++r) {
      const float rl = __builtin_amdgcn_rcpf(li_l[crow(r, hi)]);
#pragma unroll
      for (int d0 = 0; d0 < 4; ++d0) sp[((r & 3) + 8 * (r >> 2)) * 136 + d0 * 32] = f2bf(o[d0][r] * rl);
    }
  }
  asm volatile("s_waitcnt lgkmcnt(0)" ::: "memory");
  {
    const int rr = lane >> 4, ch = lane & 15;
    bf16* Aw = Ab + (long)(wid * QBLK + rr) * LDA + ch * 8; float* sw = ssq + (long)(wid * QBLK + rr) * 8;
#pragma unroll
    for (int i = 0; i < 8; ++i) {
      const u32x4 ov = *(const u32x4*)(stg + (i * 4 + rr) * 136 + ch * 8);
      bf16* gp = Aw + (long)(i * 4) * LDA; const u32x4 gv = *(const u32x4*)gp;
      float ss = 0.f; u32x4 w;
#pragma unroll
      for (int k = 0; k < 4; ++k) {
        const float a = __uint_as_float(ov[k] << 16), b = __uint_as_float(ov[k] & 0xffff0000u);
        const float ga = __uint_as_float(gv[k] << 16), gb = __uint_as_float(gv[k] & 0xffff0000u);
        ss += a * a + b * b; w[k] = cvtpk(a * ga, b * gb);
      }
      *(u32x4*)gp = w;
      ss += __shfl_xor(ss, 1); ss += __shfl_xor(ss, 2); ss += __shfl_xor(ss, 4); ss += __shfl_xor(ss, 8);
      if (ch == 0) sw[(long)(i * 4) * 8] = ss;
    }
  }
  asm volatile("s_waitcnt lgkmcnt(0)" ::: "memory");
#undef SLOAD
#undef SWRITE
#undef SWAIT
#undef RESC
#undef TMASK
}

__device__ __forceinline__ void gmlp_unit(int R0, const bf16* __restrict__ Vg, const bf16* __restrict__ Ug, const bf16* __restrict__ WSP, const float* __restrict__ bsp,
                                          const float* __restrict__ lng, const float* __restrict__ lnb, bf16* A, float* ssq, char* lds) {
  const int tid = threadIdx.x, wid = tid >> 6, lane = tid & 63, r32 = lane & 31, hi = lane >> 5;
  char* Vt = lds;
  float* st = (float*)(lds + 2 * SHM_V);
  for (int rr = 0; rr < 16; ++rr) {
    const int s = wid * 16 + rr; const bf16* p = Vg + (long)(R0 + s) * 1024 + lane * 8;
    const bf16x8 a = *(const bf16x8*)p, b = *(const bf16x8*)(p + 512);
    float x[16]; float sum = 0.f;
#pragma unroll
    for (int k = 0; k < 8; ++k) { x[k] = bf2f((bf16)a[k]); x[8 + k] = bf2f((bf16)b[k]); }
#pragma unroll
    for (int k = 0; k < 16; ++k) sum += x[k];
#pragma unroll
    for (int of = 1; of < 64; of <<= 1) sum += __shfl_xor(sum, of);
    const float mu = sum * (1.0f / 1024.0f); float q = 0.f;
#pragma unroll
    for (int k = 0; k < 16; ++k) { const float d = x[k] - mu; q += d * d; }
#pragma unroll
    for (int of = 1; of < 64; of <<= 1) q += __shfl_xor(q, of);
    if (lane == 0) { st[s] = mu; st[128 + s] = __builtin_amdgcn_rsqf(q * (1.0f / 1024.0f) + 1e-6f); }
  }
  __syncthreads();
  const int sr = tid >> 4, sc = (tid & 15) * 8;
  const int tb = wid & 3, dh = wid >> 2;
  const int vb0 = (int)(uintptr_t)Vt + v_rd_base(lane);
  float ssr[16];
#pragma unroll
  for (int r = 0; r < 16; ++r) ssr[r] = 0.f;
  for (int g = 0; g < 8; ++g) {
    { const f32x4 g0 = *(const f32x4*)(lng + g * 128 + sc), g1 = *(const f32x4*)(lng + g * 128 + sc + 4), b0 = *(const f32x4*)(lnb + g * 128 + sc), b1 = *(const f32x4*)(lnb + g * 128 + sc + 4);
#pragma unroll
      for (int q4 = 0; q4 < 4; ++q4) {
        const int s = q4 * 32 + sr; const float mu = st[s], rs = st[128 + s];
        const bf16x8 a = *(const bf16x8*)(Vg + (long)(R0 + s) * 1024 + g * 128 + sc);
        float y[8];
#pragma unroll
        for (int k = 0; k < 4; ++k) { y[k] = (bf2f((bf16)a[k]) - mu) * rs * g0[k] + b0[k]; y[4 + k] = (bf2f((bf16)a[4 + k]) - mu) * rs * g1[k] + b1[k]; }
        u32x4 w = {cvtpk(y[0], y[1]), cvtpk(y[2], y[3]), cvtpk(y[4], y[5]), cvtpk(y[6], y[7])};
        *(u32x4*)(Vt + (s >> 6) * SHM_V + v_st(s & 63, sc)) = w;
      } }
    __syncthreads();
    f32x16 o[2] = {};
    const int ntile = (tb >= 2) ? 2 : 1;
    for (int tile = 0; tile < ntile; ++tile) {
      const bf16* wp = WSP + ((long)(g * 128 + tb * 32 + r32)) * 128 + tile * 64 + 8 * hi;
      const bf16x8 pa0 = *(const bf16x8*)(wp), pa1 = *(const bf16x8*)(wp + 16), pa2 = *(const bf16x8*)(wp + 32), pa3 = *(const bf16x8*)(wp + 48);
      const int vb = vb0 + tile * SHM_V;
      if (dh == 0) { pv_one<0>(o[0], vb, pa0, pa1, pa2, pa3); pv_one<1>(o[1], vb, pa0, pa1, pa2, pa3); }
      else         { pv_one<2>(o[0], vb, pa0, pa1, pa2, pa3); pv_one<3>(o[1], vb, pa0, pa1, pa2, pa3); }
    }
#pragma unroll
    for (int r = 0; r < 16; ++r) {
      const int t = tb * 32 + crow(r, hi); const long row = R0 + t; const float bias = bsp[g * 128 + t];
#pragma unroll
      for (int dd = 0; dd < 2; ++dd) {
        const int c = g * 128 + (2 * dh + dd) * 32 + r32;
        const float res = bf2f(Ug[row * 1024 + c]) * (o[dd][r] + bias);
        ssr[r] += res * res;
        bf16* p = A + row * LDA + 1024 + c; *p = f2bf(res * bf2f(*p));
      }
    }
    __syncthreads();
  }
#pragma unroll
  for (int r = 0; r < 16; ++r) {
    float ss = ssr[r];
    ss += __shfl_xor(ss, 1); ss += __shfl_xor(ss, 2); ss += __shfl_xor(ss, 4); ss += __shfl_xor(ss, 8); ss += __shfl_xor(ss, 16);
    if (r32 == 0) ssq[(long)(R0 + tb * 32 + crow(r, hi)) * 2 + dh] = ss;
  }
}
#undef KSWZ
#undef SBAR
}
namespace cg = cooperative_groups;
#define LAS __attribute__((address_space(3)))
typedef unsigned short bf16;
typedef unsigned v4u __attribute__((ext_vector_type(4)));
typedef float f32x4 __attribute__((ext_vector_type(4)));
constexpr int NWAVES = 8;
constexpr int BATCH = 4, SEQ = 8192, DM = 1024, M = BATCH * SEQ;
constexpr int NPAD = 4864;
constexpr float EPS = 1e-6f;
constexpr size_t MiB = 1u << 20;
constexpr size_t WS_WIN = 0, WS_WUQ = 10 * MiB, WS_WUKV = 11 * MiB, WS_WOUT = 12 * MiB, WS_WSP = 16 * MiB, WS_ROPE = 17 * MiB;
constexpr size_t WS_RSX = 18 * MiB, WS_RSQ = WS_RSX + 128 * 1024, WS_RSKV = WS_RSQ + 128 * 1024;
constexpr size_t WS_SSQM = 19 * MiB, WS_SSQG = 20 * MiB, WS_HSQ = 21 * MiB;
constexpr size_t WS_XB = 32 * MiB, WS_Q = 32 * MiB;
constexpr size_t WS_QLAT = 96 * MiB, WS_KVLAT = 120 * MiB, WS_U = 136 * MiB, WS_V = 200 * MiB, WS_AMIX = 264 * MiB, WS_K = 392 * MiB, WS_VV = 440 * MiB, WS_END = 504 * MiB;
constexpr int RING_BYTES = 131072, TAB_OFF = RING_BYTES, LDS_BYTES = 147456;

__constant__ float INVF[16] = {1.0f, 0.5623413251903491f, 0.31622776601683794f, 0.1778279410038923f, 0.1f, 0.05623413251903491f, 0.03162277660168379f, 0.01778279410038923f,
                               0.01f, 0.005623413251903491f, 0.003162277660168379f, 0.001778279410038923f, 0.001f, 0.0005623413251903491f, 0.00031622776601683794f, 0.0001778279410038923f};

#define LDS_WAIT() asm volatile("s_waitcnt lgkmcnt(0)" ::: "memory")
__device__ __forceinline__ unsigned pk2(float lo, float hi) { return pg8::cvt_pk_bf16(lo, hi); }
__device__ __forceinline__ float wave_sum(float v) {
#pragma unroll
    for (int o = 1; o < 64; o <<= 1) v += __shfl_xor(v, o);
    return v;
}
__device__ __forceinline__ void transpose_item(const float* W, int N, int K, bf16* WT, int dst_row, int k0, int n0, const float* g1, const float* g2, int ksplit, LAS float* scr, int lane) {
#pragma unroll 8
    for (int i = 0; i < 32; ++i) { const int kk = 2 * i + (lane >> 5), k = k0 + kk; const float gk = (k < ksplit) ? g1[k] : g2[k - ksplit];
        scr[kk * 33 + (lane & 31)] = W[(size_t)k * N + n0 + (lane & 31)] * gk; }
    LDS_WAIT(); asm volatile("" ::: "memory");
    const int c = lane & 7;
#pragma unroll
    for (int j = 0; j < 4; ++j) { const int n = (lane >> 3) + 8 * j; const LAS float* s = scr + (8 * c) * 33 + n;
        v4u o; o.x = pk2(s[0 * 33], s[1 * 33]); o.y = pk2(s[2 * 33], s[3 * 33]); o.z = pk2(s[4 * 33], s[5 * 33]); o.w = pk2(s[6 * 33], s[7 * 33]);
        *(v4u*)(WT + (size_t)(dst_row + n) * K + k0 + 8 * c) = o; }
    LDS_WAIT(); asm volatile("" ::: "memory");
}

struct Args { const float* in[15]; float* out; unsigned char* ws; int ph_lo, ph_hi; };

__global__ void __launch_bounds__(NWAVES * 64, 2) fwd_kernel(Args args) {
    extern __shared__ __attribute__((aligned(16))) unsigned char lds[];
    LAS unsigned char* ldsl = (LAS unsigned char*)lds;
    const int tid = threadIdx.x, lane = tid & 63, wave = __builtin_amdgcn_readfirstlane(tid >> 6);
    const int G = gridDim.x, bx = blockIdx.x;
    const int vcu = (G % 8 == 0) ? (bx % 8) * (G / 8) + bx / 8 : bx;
    const int gw = vcu * NWAVES + wave, NGW = G * NWAVES;
    unsigned char* ws = args.ws;
    const float* x = args.in[0]; const float* norm_in_g = args.in[1]; const float* w_in = args.in[2]; const float* q_norm_g = args.in[3]; const float* w_uq = args.in[4];
    const float* kv_norm_g = args.in[5]; const float* w_ukv = args.in[6]; const float* ln_g = args.in[7]; const float* ln_b = args.in[8]; const float* w_sp = args.in[9];
    const float* b_sp = args.in[10]; const float* on_mla_g = args.in[11]; const float* on_gmlp_g = args.in[12]; const float* w_out = args.in[13]; const float* fin_g = args.in[14];
    bf16* WIN = (bf16*)(ws + WS_WIN); bf16* WUQ = (bf16*)(ws + WS_WUQ); bf16* WUKV = (bf16*)(ws + WS_WUKV); bf16* WOUT = (bf16*)(ws + WS_WOUT); bf16* WSP = (bf16*)(ws + WS_WSP);
    float* ROPE = (float*)(ws + WS_ROPE); float* RSX = (float*)(ws + WS_RSX); float* RSQ = (float*)(ws + WS_RSQ); float* RSKV = (float*)(ws + WS_RSKV);
    float* SSQM = (float*)(ws + WS_SSQM); float* SSQG = (float*)(ws + WS_SSQG); float* HSQ = (float*)(ws + WS_HSQ);
    bf16* XB = (bf16*)(ws + WS_XB); bf16* QB_ = (bf16*)(ws + WS_Q); bf16* QLAT = (bf16*)(ws + WS_QLAT); bf16* KVLAT = (bf16*)(ws + WS_KVLAT);
    bf16* UB = (bf16*)(ws + WS_U); bf16* VB = (bf16*)(ws + WS_V); bf16* AMIX = (bf16*)(ws + WS_AMIX); bf16* KB = (bf16*)(ws + WS_K); bf16* VV = (bf16*)(ws + WS_VV);
    const int lo = args.ph_lo, hi = args.ph_hi;
#ifndef PHASE_MASK
#define PHASE_MASK 0x7f
#endif
#define IN(k) (lo <= (k) && (k) < hi)
#define SEAM(k) do { if (IN(k) && IN((k) + 1)) { cg::this_grid().sync(); } } while (0)

    if (((PHASE_MASK >> 0) & 1) && IN(0)) {
        LAS float* scr = (LAS float*)(ldsl + wave * 16384);
        constexpr int I_IN = 16 * 149, I_UQ = 6 * 24, I_UKV = 4 * 48, I_OUT = 32 * 32, NITEMS = I_IN + I_UQ + I_UKV + I_OUT;
        for (int it = gw; it < NITEMS; it += NGW) {
            int r = it;
            if (r < I_IN) { const int kb = r / 149, nb = r % 149, n0 = nb * 32; transpose_item(w_in, 4768, 1024, WIN, n0 + (n0 >= 672 ? 96 : 0), kb * 64, n0, norm_in_g, norm_in_g, 1 << 30, scr, lane); continue; } r -= I_IN;
            if (r < I_UQ) { const int kb = r / 24, nb = r % 24; transpose_item(w_uq, 768, 384, WUQ, nb * 32, kb * 64, nb * 32, q_norm_g, q_norm_g, 1 << 30, scr, lane); continue; } r -= I_UQ;
            if (r < I_UKV) { const int kb = r / 48, nb = r % 48; transpose_item(w_ukv, 1536, 256, WUKV, nb * 32, kb * 64, nb * 32, kv_norm_g, kv_norm_g, 1 << 30, scr, lane); continue; } r -= I_UKV;
            { const int kb = r / 32, nb = r % 32; transpose_item(w_out, 1024, 2048, WOUT, nb * 32, kb * 64, nb * 32, on_mla_g, on_gmlp_g, 1024, scr, lane); }
        }
        const int gt = vcu * (NWAVES * 64) + tid, NGT = G * NWAVES * 64;
        for (int i = gt; i < 96 * 1024 / 8; i += NGT) *(v4u*)(WIN + (size_t)672 * 1024 + (size_t)i * 8) = (v4u){0u, 0u, 0u, 0u};
        for (int i = gt; i < 8 * 128 * 128 / 8; i += NGT) {
            const int e = i * 8, s0 = e & 127, t = (e >> 7) & 127; const bool keep = (s0 >> 6) <= (t >> 6);
            const f32x4 a = *(const f32x4*)(w_sp + e), b = *(const f32x4*)(w_sp + e + 4);
            v4u o = {pk2(a[0], a[1]), pk2(a[2], a[3]), pk2(b[0], b[1]), pk2(b[2], b[3])}; if (!keep) o = (v4u){0u, 0u, 0u, 0u};
            *(v4u*)(WSP + e) = o;
        }
        for (int i = gt; i < SEQ * 16; i += NGT) {
            const int pos = i >> 4, fi = i & 15; const float ang = (float)pos * INVF[fi];
            const double rev = (double)ang * 0.15915494309189535; const float fr = (float)(rev - floor(rev));
            ROPE[2 * i] = __builtin_amdgcn_cosf(fr); ROPE[2 * i + 1] = __builtin_amdgcn_sinf(fr);
        }
        for (int m = gw; m < M; m += NGW) {
            const f32x4* xr = (const f32x4*)(x + (size_t)m * DM) + lane; f32x4 v[4]; float s = 0.f;
#pragma unroll
            for (int j = 0; j < 4; ++j) { v[j] = xr[64 * j]; s += (v[j][0] * v[j][0] + v[j][1] * v[j][1]) + (v[j][2] * v[j][2] + v[j][3] * v[j][3]); }
            s = wave_sum(s);
            unsigned long long* o8 = (unsigned long long*)(XB + (size_t)m * DM) + lane;
#pragma unroll
            for (int j = 0; j < 4; ++j) o8[64 * j] = (unsigned long long)pk2(v[j][0], v[j][1]) | ((unsigned long long)pk2(v[j][2], v[j][3]) << 32);
            if (lane == 0) RSX[m] = __builtin_amdgcn_rsqf(s * (1.0f / DM) + EPS);
        }
        __syncthreads();
    }
    SEAM(0);
    if (((PHASE_MASK >> 1) & 1) && IN(1)) {
        pg8::Gemm g{XB, WIN, M, NPAD, DM}; pg8::StaticOrder S; S.init(M, NPAD, G, bx);
        pg8::EpiProj E{RSX, QLAT, KVLAT, KB, AMIX, UB, VB, ROPE};
        pg8::gemm_phase<pg8::EpiProj, pg8::StaticOrder, true, true>(ldsl, g, S, E);
    }
    SEAM(1);
    if (((PHASE_MASK >> 2) & 1) && IN(2)) {
        for (int m = gw; m < M; m += NGW) {
            const unsigned* pq = (const unsigned*)(QLAT + (size_t)m * 384) + lane * 3; float s = 0.f;
#pragma unroll
            for (int j = 0; j < 3; ++j) { const unsigned w = pq[j]; const float a = __uint_as_float(w << 16), b = __uint_as_float(w & 0xffff0000u); s += a * a + b * b; }
            const unsigned* pk = (const unsigned*)(KVLAT + (size_t)m * 256) + lane * 2; float s2 = 0.f;
#pragma unroll
            for (int j = 0; j < 2; ++j) { const unsigned w = pk[j]; const float a = __uint_as_float(w << 16), b = __uint_as_float(w & 0xffff0000u); s2 += a * a + b * b; }
            s = wave_sum(s); s2 = wave_sum(s2);
            if (lane == 0) { RSQ[m] = __builtin_amdgcn_rsqf(s * (1.0f / 384.0f) + EPS); RSKV[m] = __builtin_amdgcn_rsqf(s2 * (1.0f / 256.0f) + EPS); }
        }
    }
    SEAM(2);
    if (((PHASE_MASK >> 3) & 1) && IN(3)) {
#ifndef EXP_NOQ
        { int kq = 384; asm volatile("" : "+s"(kq)); pg8::Gemm g{QLAT, WUQ, M, 768, kq}; pg8::StaticOrder S; S.init(M, 768, G, bx); pg8::EpiQ E{RSQ, QB_, ROPE};
          pg8::gemm_phase<pg8::EpiQ, pg8::StaticOrder, true, true>(ldsl, g, S, E); }
#endif
#ifndef EXP_NOKV
        { int kk = 256; asm volatile("" : "+s"(kk)); pg8::Gemm g{KVLAT, WUKV, M, 1536, kk}; pg8::StaticOrder S; S.init(M, 1536, G, bx); pg8::EpiKV E{RSKV, KB, VV};
          pg8::gemm_phase<pg8::EpiKV, pg8::StaticOrder, true, true>(ldsl, g, S, E); }
#endif
#ifndef EXP_NOGMLP
        __syncthreads();
        for (int un = vcu; un < M / 128; un += G)
            att::gmlp_unit(un * 128, VB, UB, WSP, b_sp, ln_g, ln_b, AMIX, SSQG, (char*)lds);
#endif
    }
    SEAM(3);
    if (((PHASE_MASK >> 4) & 1) && IN(4)) {
        for (int un = vcu; un < 1024; un += G) {
            const int v = un & 255, i = un >> 8, s = v & 7, bh = v >> 3; const int qb = (i == 0) ? s : (i == 1) ? 15 - s : (i == 2) ? 16 + s : 31 - s;
            const int b = bh >> 3, h = bh & 7; const size_t r0 = (size_t)b * SEQ, q0 = r0 + (size_t)qb * 256;
            att::attn_unit(QB_ + q0 * 768 + h * 96, KB + r0 * 768 + h * 96, VV + r0 * 1024 + h * 128, AMIX + q0 * 2048 + h * 128, SSQM + q0 * 8 + h, 4 * qb + 4, (char*)lds);
            __syncthreads();
        }
    }
    SEAM(4);
    if (((PHASE_MASK >> 5) & 1) && IN(5)) {
        pg8::Gemm g{AMIX, WOUT, M, DM, 2048}; pg8::StaticOrder S; S.init(M, DM, G, bx);
        pg8::EpiOut E{x, args.out, SSQM, SSQG, HSQ, (LAS float*)(ldsl + TAB_OFF)};
        pg8::gemm_phase<pg8::EpiOut, pg8::StaticOrder, true, true>(ldsl, g, S, E);
    }
    SEAM(5);
    if (((PHASE_MASK >> 6) & 1) && IN(6)) {
        for (int m = gw; m < M; m += NGW) {
            float s = (lane < 16) ? HSQ[(size_t)m * 16 + lane] : 0.f; s = wave_sum(s);
            const float rstd = __builtin_amdgcn_rsqf(s * (1.0f / DM) + EPS);
            f32x4* orow = (f32x4*)(args.out + (size_t)m * DM) + lane; const f32x4* gp = (const f32x4*)fin_g + lane;
#pragma unroll
            for (int j = 0; j < 4; ++j) orow[64 * j] = orow[64 * j] * rstd * gp[64 * j];
        }
    }
#undef IN
#undef SEAM
}

#ifndef N_LAUNCHES
#define N_LAUNCHES 1
#endif
extern "C" void kernel_launch(void* const* d_in, const int* in_sizes, int n_in, void* d_out, int out_size, void* d_ws, size_t ws_size, hipStream_t stream) {
    static int grid = 0;
    if (grid == 0) {
        if (n_in != 15 || out_size != M * DM || ws_size < WS_END) { fprintf(stderr, "kernel_launch: unexpected shapes (n_in %d out %d ws %zu)\n", n_in, out_size, ws_size); grid = -1; return; }
        int dev = 0, cus = 0, per_cu = 0;
        hipGetDevice(&dev); hipDeviceGetAttribute(&cus, hipDeviceAttributeMultiprocessorCount, dev);
        if (hipFuncSetAttribute((const void*)fwd_kernel, hipFuncAttributeMaxDynamicSharedMemorySize, LDS_BYTES) != hipSuccess) { fprintf(stderr, "kernel_launch: hipFuncSetAttribute failed\n"); grid = -1; return; }
        if (hipOccupancyMaxActiveBlocksPerMultiprocessor(&per_cu, (const void*)fwd_kernel, NWAVES * 64, LDS_BYTES) != hipSuccess || per_cu < 1) { fprintf(stderr, "kernel_launch: occupancy query says %d\n", per_cu); per_cu = 1; }
        (void)hipGetLastError();
        grid = cus * (per_cu > 1 ? 1 : per_cu);
        if (grid % 8 != 0 || grid <= 0) { fprintf(stderr, "kernel_launch: odd grid %d\n", grid); }
    }
    if (grid < 0) return;
    Args a{};
    for (int i = 0; i < 15; ++i) a.in[i] = (const float*)d_in[i];
    a.out = (float*)d_out; a.ws = (unsigned char*)d_ws;
    if (N_LAUNCHES == 1) {
        a.ph_lo = 0; a.ph_hi = 7; void* kargs[] = {&a};
        hipError_t e = hipLaunchCooperativeKernel((const void*)fwd_kernel, dim3(grid), dim3(NWAVES * 64), kargs, LDS_BYTES, stream);
        if (e != hipSuccess) fprintf(stderr, "cooperative launch failed: %s (grid %d)\n", hipGetErrorString(e), grid);
    } else {
        for (int p = 0; p < 7; ++p) { a.ph_lo = p; a.ph_hi = p + 1; hipLaunchKernelGGL(fwd_kernel, dim3(grid), dim3(NWAVES * 64), LDS_BYTES, stream, a); }
    }
}
```

```cpp
#include <hip/hip_runtime.h>
#include <hip/hip_cooperative_groups.h>
#include <cstdio>
#include <cstdint>
#include <cmath>
namespace pg8 {
#define PG8_LAS __attribute__((address_space(3)))
typedef unsigned short bf16_t;
typedef short bf16x8 __attribute__((ext_vector_type(8)));
typedef float f32x4 __attribute__((ext_vector_type(4)));
typedef unsigned u32x4 __attribute__((ext_vector_type(4)));
constexpr int BM = 256, BK = 64, HALF = 128, HTB = HALF * BK * 2  , STAGE_BYTES = 8 * HTB, NXCD = 8, WGM = 8;

__host__ __device__ __forceinline__ int lds_byte(int r, int c) { const int st = (r >> 4) * 2 + (c >> 5), rr = r & 15, cc = c & 31, ob = rr * 64 + cc * 2; return st * 1024 + (ob ^ (((ob >> 9) & 1) << 5)); }
__host__ __device__ __forceinline__ void stage_rc(int b, int& R, int& C) { const int st = b / 1024, sb = b % 1024, swz = sb ^ (((sb >> 9) & 1) << 5); R = (st >> 1) * 16 + swz / 64; C = (st & 1) * 32 + (swz % 64) / 2; }
__host__ __device__ __forceinline__ int perm32(int rho) { const int n = rho >> 4, i = rho & 15; return 8 * (i >> 2) + 4 * n + (i & 3); }

struct Unit { int pm, pn; };
struct Gemm { const bf16_t* A; const bf16_t* Bt; int M, N, K; };

struct StaticOrder {
    int nM, nN, nwg, G, c;
    __host__ __device__ void init(int M, int N, int G_, int c_) { nM = M / BM; nN = N / BM; nwg = nM * nN; G = G_; c = c_; }
    __host__ __device__ bool next(int i, Unit& u) const {
        const long L = (long)i * G + c; if (L >= nwg) return false;
        int wgid = (int)L; { const int q = nwg / NXCD, r = nwg % NXCD, xcd = wgid % NXCD, off = wgid / NXCD; wgid = (xcd < r ? xcd * (q + 1) : r * (q + 1) + (xcd - r) * q) + off; }
        const int nig = WGM * nN, gid = wgid / nig, fm = gid * WGM, gsz = (nM - fm) < WGM ? (nM - fm) : WGM;
        u.pm = fm + ((wgid % nig) % gsz); u.pn = (wgid % nig) / gsz; return true;
    }
    __device__ __forceinline__ void a_ready(const Unit&) const {}
    __device__ __forceinline__ void done(const Unit&) const {}
};

__device__ __forceinline__ unsigned cvt_pk_bf16(float lo, float hi) { unsigned r; asm volatile("v_cvt_pk_bf16_f32 %0, %1, %2" : "=v"(r) : "v"(lo), "v"(hi)); return r; }
typedef float f32x2 __attribute__((ext_vector_type(2)));
__device__ __forceinline__ f32x2 gelu_pk(f32x2 v) {
    const f32x2 av = __builtin_elementwise_abs(v), d = av * 0.2316418882f + 1.0f;
    f32x2 t; t.x = __builtin_amdgcn_rcpf(d.x); t.y = __builtin_amdgcn_rcpf(d.y);
    f32x2 q = t * 0.5307027145f + (-0.7265760135f); q = q * t + 0.7107068705f; q = q * t + (-0.142248368f); q = q * t + 0.127414796f; q = q * t;
    const f32x2 s = (v * v) * (-0.72134752044f);
    f32x2 e; e.x = __builtin_amdgcn_exp2f(s.x); e.y = __builtin_amdgcn_exp2f(s.y);
    const f32x2 m = v * (q * e), r = v - m;
    f32x2 o; o.x = v.x < 0.f ? m.x : r.x; o.y = v.y < 0.f ? m.y : r.y; return o;
}

__device__ __forceinline__ float silu_f(float v) { return v * __builtin_amdgcn_rcpf(1.0f + __builtin_amdgcn_exp2f(-1.4426950408889634f * v)); }
__device__ __forceinline__ u32x4 pack8(const f32x4 v0, const f32x4 v1) { u32x4 w; w.x = cvt_pk_bf16(v0[0], v0[1]); w.y = cvt_pk_bf16(v0[2], v0[3]); w.z = cvt_pk_bf16(v1[0], v1[1]); w.w = cvt_pk_bf16(v1[2], v1[3]); return w; }
__device__ __forceinline__ void rope8(f32x4& v0, f32x4& v1, const char* tb_u, unsigned tb_l, int fq) {
    const f32x4* tb = (const f32x4*)(tb_u + tb_l);
    const f32x4 t0 = tb[0], t1 = tb[1], t2 = tb[2], t3 = tb[3];
    const float sg = (fq < 2) ? -1.0f : 1.0f;
    f32x4 o0, o1;
#pragma unroll
    for (int k = 0; k < 4; ++k) { o0[k] = __shfl_xor(v0[k], 32) * sg; o1[k] = __shfl_xor(v1[k], 32) * sg; }
    v0[0] = v0[0] * t0[0] + o0[0] * t0[1]; v0[1] = v0[1] * t0[2] + o0[1] * t0[3];
    v0[2] = v0[2] * t1[0] + o0[2] * t1[1]; v0[3] = v0[3] * t1[2] + o0[3] * t1[3];
    v1[0] = v1[0] * t2[0] + o1[0] * t2[1]; v1[1] = v1[1] * t2[2] + o1[1] * t2[3];
    v1[2] = v1[2] * t3[0] + o1[2] * t3[1]; v1[3] = v1[3] * t3[2] + o1[3] * t3[3];
}

struct EpiProj {
    static constexpr bool PERM = true, AFTER_DRAIN = false, MIDK = false;
    const float* rsx; bf16_t *QLAT, *KVLAT, *KB, *AMIX, *U, *V; const float* rope;
    __device__ __forceinline__ void begin(const Unit&, int) const {}
    __device__ __forceinline__ void operator()(const f32x4 (&acc)[2][2][4][2], const Unit& u, int, int wr, int wc, int fr, int fq) const {
        const int rl = wr * 64 + fr;
        const int rowu = u.pm * BM;
        float rs[2][4];
#pragma unroll
        for (int ai = 0; ai < 2; ++ai)
#pragma unroll
            for (int m = 0; m < 4; ++m) rs[ai][m] = *(const float*)((const char*)(rsx + rowu + ai * HALF + m * 16) + (unsigned)rl * 4u);
#pragma unroll
        for (int bj = 0; bj < 2; ++bj) {
            const int cg = u.pn * BM + bj * HALF + wc * 32;
            int kind = 0, ld = 0, cofs = 0; bf16_t* base = nullptr;
            if (cg < 384) { kind = 0; base = QLAT; ld = 384; cofs = cg; }
            else if (cg < 640) { kind = 0; base = KVLAT; ld = 256; cofs = cg - 384; }
            else if (cg < 672) { kind = 3; }
            else if (cg < 768) { kind = 4; }
            else if (cg < 1792) { kind = 1; base = AMIX; ld = 2048; cofs = cg - 768; }
            else if (cg < 2816) { kind = 2; base = U; ld = 1024; cofs = cg - 1792; }
            else if (cg < 3840) { kind = 2; base = V; ld = 1024; cofs = cg - 2816; }
            else { kind = 1; base = AMIX; ld = 2048; cofs = cg - 3840 + 1024; }
            if (kind == 4) continue;
            if (kind == 3) {
                const unsigned kl = (unsigned)(rl * 768 + 64 + 8 * fq) * 2u, tl = (unsigned)(rl * 16 + 8 * (fq & 1)) * 8u;
#pragma unroll
                for (int ai = 0; ai < 2; ++ai)
#pragma unroll
                    for (int m = 0; m < 4; ++m) {
                        const int rb = rowu + ai * HALF + m * 16;
                        f32x4 v0 = acc[ai][bj][m][0] * rs[ai][m], v1 = acc[ai][bj][m][1] * rs[ai][m];
                        rope8(v0, v1, (const char*)(rope + (size_t)(rb & 8191) * 32), tl, fq);
                        const u32x4 w = pack8(v0, v1);
                        char* kp = (char*)(KB + (size_t)rb * 768) + kl;
#pragma unroll
                        for (int h = 0; h < 8; ++h) *(u32x4*)(kp + h * 192) = w;
                        asm volatile("" ::: "memory");
                    }
                continue;
            }
            const unsigned ll = (unsigned)(rl * ld + 8 * fq) * 2u;
#pragma unroll
            for (int ai = 0; ai < 2; ++ai)
#pragma unroll
                for (int m = 0; m < 4; ++m) {
                    const int rb = rowu + ai * HALF + m * 16;
                    f32x4 v0 = acc[ai][bj][m][0] * rs[ai][m], v1 = acc[ai][bj][m][1] * rs[ai][m];
                    if (kind == 1) {
#pragma unroll
                        for (int k = 0; k < 4; ++k) { v0[k] = silu_f(v0[k]); v1[k] = silu_f(v1[k]); }
                    } else if (kind == 2) {
                        const f32x2 a = gelu_pk((f32x2){v0[0], v0[1]}), b = gelu_pk((f32x2){v0[2], v0[3]}), c = gelu_pk((f32x2){v1[0], v1[1]}), d = gelu_pk((f32x2){v1[2], v1[3]});
                        v0 = (f32x4){a.x, a.y, b.x, b.y}; v1 = (f32x4){c.x, c.y, d.x, d.y};
                    }
                    *(u32x4*)((char*)(base + (size_t)rb * ld + cofs) + ll) = pack8(v0, v1);
                }
        }
    }
};

struct EpiQ {
    static constexpr bool PERM = true, AFTER_DRAIN = false, MIDK = false;
    const float* rsq; bf16_t* Q; const float* rope;
    __device__ __forceinline__ void begin(const Unit&, int) const {}
    __device__ __forceinline__ void operator()(const f32x4 (&acc)[2][2][4][2], const Unit& u, int, int wr, int wc, int fr, int fq) const {
        const int rl = wr * 64 + fr, rowu = u.pm * BM;
        const unsigned ql = (unsigned)(rl * 768 + 8 * fq) * 2u, tl = (unsigned)(rl * 16 + 8 * (fq & 1)) * 8u;
        float rs[2][4];
#pragma unroll
        for (int ai = 0; ai < 2; ++ai)
#pragma unroll
            for (int m = 0; m < 4; ++m) rs[ai][m] = *(const float*)((const char*)(rsq + rowu + ai * HALF + m * 16) + (unsigned)rl * 4u);
#pragma unroll
        for (int bj = 0; bj < 2; ++bj) {
            const int cg = u.pn * BM + bj * HALF + wc * 32; const int gi = cg >> 5; const bool isrope = (gi % 3) == 2;
#pragma unroll
            for (int ai = 0; ai < 2; ++ai)
#pragma unroll
                for (int m = 0; m < 4; ++m) {
                    const int rb = rowu + ai * HALF + m * 16;
                    f32x4 v0 = acc[ai][bj][m][0] * rs[ai][m], v1 = acc[ai][bj][m][1] * rs[ai][m];
                    if (isrope) rope8(v0, v1, (const char*)(rope + (size_t)(rb & 8191) * 32), tl, fq);
                    *(u32x4*)((char*)(Q + (size_t)rb * 768 + cg) + ql) = pack8(v0, v1);
                    if (isrope) asm volatile("" ::: "memory");
                }
        }
    }
};

struct EpiKV {
    static constexpr bool PERM = true, AFTER_DRAIN = false, MIDK = false;
    const float* rskv; bf16_t *KB, *VV;
    __device__ __forceinline__ void begin(const Unit&, int) const {}
    __device__ __forceinline__ void operator()(const f32x4 (&acc)[2][2][4][2], const Unit& u, int, int wr, int wc, int fr, int fq) const {
        const int rl = wr * 64 + fr, rowu = u.pm * BM;
        float rs[2][4];
#pragma unroll
        for (int ai = 0; ai < 2; ++ai)
#pragma unroll
            for (int m = 0; m < 4; ++m) rs[ai][m] = *(const float*)((const char*)(rskv + rowu + ai * HALF + m * 16) + (unsigned)rl * 4u);
#pragma unroll
        for (int bj = 0; bj < 2; ++bj) {
            const int cg = u.pn * BM + bj * HALF + wc * 32; const int gi = cg >> 5, h = gi / 6, jg = gi - 6 * h;
            bf16_t* base; int ld;
            if (jg < 2) { base = KB + h * 96 + jg * 32; ld = 768; } else { base = VV + h * 128 + (jg - 2) * 32; ld = 1024; }
            const unsigned ll = (unsigned)(rl * ld + 8 * fq) * 2u;
#pragma unroll
            for (int ai = 0; ai < 2; ++ai)
#pragma unroll
                for (int m = 0; m < 4; ++m) {
                    const int rb = rowu + ai * HALF + m * 16;
                    const f32x4 v0 = acc[ai][bj][m][0] * rs[ai][m], v1 = acc[ai][bj][m][1] * rs[ai][m];
                    *(u32x4*)((char*)(base + (size_t)rb * ld) + ll) = pack8(v0, v1);
                }
        }
    }
};

struct EpiOut {
    static constexpr bool PERM = false, AFTER_DRAIN = false, MIDK = true;
    const float* x; float* out; const float* ssqm; const float* ssqg; float* hsq; PG8_LAS float* tab;
    __device__ __forceinline__ void begin(const Unit& u, int ui) const {
        const int tid = threadIdx.x;
        if (tid < 256) {
            const int row = u.pm * BM + tid;
            const f32x4 a = *(const f32x4*)(ssqm + (size_t)row * 8), b = *(const f32x4*)(ssqm + (size_t)row * 8 + 4);
            const float sm = ((a[0] + a[1]) + (a[2] + a[3])) + ((b[0] + b[1]) + (b[2] + b[3]));
            const float sg = ssqg[(size_t)row * 2] + ssqg[(size_t)row * 2 + 1];
            const float rm = __builtin_amdgcn_rsqf(sm * (1.0f / 1024.0f) + 1e-6f), rg = __builtin_amdgcn_rsqf(sg * (1.0f / 1024.0f) + 1e-6f);
            tab[(ui & 1) * 512 + tid * 2] = rm / rg; tab[(ui & 1) * 512 + tid * 2 + 1] = rg;
        }
    }
    __device__ __forceinline__ void mid(f32x4 (&acc)[2][2][4][2], const Unit&, int ui, int wr, int, int fr, int) const {
#pragma unroll
        for (int ai = 0; ai < 2; ++ai)
#pragma unroll
            for (int m = 0; m < 4; ++m) {
                const float f = tab[(ui & 1) * 512 + (ai * HALF + wr * 64 + m * 16 + fr) * 2];
#pragma unroll
                for (int bj = 0; bj < 2; ++bj)
#pragma unroll
                    for (int n = 0; n < 2; ++n) acc[ai][bj][m][n] *= f;
            }
    }
    __device__ __forceinline__ void operator()(const f32x4 (&acc)[2][2][4][2], const Unit& u, int ui, int wr, int wc, int fr, int fq) const {
        const int rl = wr * 64 + fr, rowu = u.pm * BM;
        const unsigned ol = (unsigned)(rl * 1024 + wc * 32 + 4 * fq) * 4u;
#pragma unroll
        for (int ai = 0; ai < 2; ++ai)
#pragma unroll
            for (int m = 0; m < 4; ++m) {
                const int r = ai * HALF + m * 16 + rl; const int rb = rowu + ai * HALF + m * 16;
                const float g = tab[(ui & 1) * 512 + r * 2 + 1];
                float ss = 0.f;
#pragma unroll
                for (int bj = 0; bj < 2; ++bj)
#pragma unroll
                    for (int n = 0; n < 2; ++n) {
                        const size_t offu = ((size_t)rb * 1024 + u.pn * BM + bj * HALF + n * 16) * 4;
                        const f32x4 xv = *(const f32x4*)((const char*)x + offu + ol);
                        const f32x4 hv = xv + acc[ai][bj][m][n] * g;
                        ss += (hv[0] * hv[0] + hv[1] * hv[1]) + (hv[2] * hv[2] + hv[3] * hv[3]);
                        *(f32x4*)((char*)out + offu + ol) = hv;
                    }
                ss += __shfl_xor(ss, 16); ss += __shfl_xor(ss, 32);
                if (fq == 0) *(float*)((char*)(hsq + (size_t)rb * 16 + u.pn * 4 + wc) + (unsigned)rl * 64u) = ss;
            }
    }
};

template <class Epi, class Sched, bool ALIGN_EPI = false, bool SP2 = false>
__device__ __forceinline__ void gemm_phase(PG8_LAS unsigned char* lds, const Gemm g, const Sched& S, const Epi& E) {
    const int tid = threadIdx.x, wid = __builtin_amdgcn_readfirstlane(tid >> 6), lane = tid & 63, wr = wid >> 2, wc = wid & 3, fr = lane & 15, fq = lane >> 4;
    const int K = g.K, nt = K / BK;
    unsigned voffA[2], voffB[2];
#pragma unroll
    for (int i = 0; i < 2; ++i) { int R, C; stage_rc(tid * 16 + i * 8192, R, C); const int Rb = Epi::PERM ? ((R & ~31) + perm32(R & 31)) : R;
        voffA[i] = (unsigned)(R * K + C) * 2u; voffB[i] = (unsigned)(Rb * K + C) * 2u; }
    const size_t kstep = (size_t)(BK * 2);
    const size_t hstep = (size_t)HALF * K * 2;
    const size_t tstep = 2 * hstep;
    const unsigned ldsw = (unsigned)wid * 1024u;
    const int aoff = lds_byte(wr * 64 + fr, fq * 8), boff = lds_byte(wc * 32 + fr, fq * 8);
#define PG8_SA(b, h) (((b) * 2 + (h)) * HTB)
#define PG8_SB(b, h) ((4 + (b) * 2 + (h)) * HTB)
#define PG8_STAGE(bufoff, gbase, voff) do { _Pragma("unroll") for (int _i = 0; _i < 2; ++_i) \
        __builtin_amdgcn_global_load_lds((const unsigned*)((const char*)(gbase) + (voff)[_i]), (PG8_LAS unsigned*)(lds + (bufoff) + ldsw + _i * 8192), 16, 0, 0); } while (0)
#define PG8_LDA(dst, b, h) do { _Pragma("unroll") for (int m = 0; m < 4; ++m) _Pragma("unroll") for (int k = 0; k < 2; ++k) dst[m][k] = *(const PG8_LAS bf16x8*)(lds + PG8_SA(b, h) + aoff + m * 2048 + k * 1024); } while (0)
#define PG8_LDB(dst, b, h) do { _Pragma("unroll") for (int n = 0; n < 2; ++n) _Pragma("unroll") for (int k = 0; k < 2; ++k) dst[n][k] = *(const PG8_LAS bf16x8*)(lds + PG8_SB(b, h) + boff + n * 2048 + k * 1024); } while (0)
#define PG8_MMA(ai, bj, At, Bt) do { __builtin_amdgcn_s_setprio(1); _Pragma("unroll") for (int m = 0; m < 4; ++m) _Pragma("unroll") for (int n = 0; n < 2; ++n) _Pragma("unroll") for (int k = 0; k < 2; ++k) \
        acc[ai][bj][m][n] = __builtin_amdgcn_mfma_f32_16x16x32_bf16(Bt[n][k], At[m][k], acc[ai][bj][m][n], 0, 0, 0); __builtin_amdgcn_s_setprio(0); } while (0)
#define PG8_WAIT_V(n) asm volatile("s_waitcnt vmcnt(" #n ")" ::: "memory")
#define PG8_WAIT_L(n) asm volatile("s_waitcnt lgkmcnt(" #n ")" ::: "memory")
#define PG8_BAR __builtin_amdgcn_s_barrier()
#define PG8_SCHED __builtin_amdgcn_sched_barrier(0)
    Unit cur, nxt; int ui = 0;
    if (!S.next(0, cur)) return;
    E.begin(cur, 0);
    f32x4 acc[2][2][4][2];
#pragma unroll
    for (int a = 0; a < 2; ++a)
#pragma unroll
        for (int b = 0; b < 2; ++b)
#pragma unroll
            for (int m = 0; m < 4; ++m)
#pragma unroll
                for (int n = 0; n < 2; ++n) acc[a][b][m][n] = (f32x4){0.f, 0.f, 0.f, 0.f};
    bf16x8 At[4][2], B0[2][2], B1[2][2];
    const char* cA = (const char*)g.A + (size_t)cur.pm * tstep; const char* cB = (const char*)g.Bt + (size_t)cur.pn * tstep;
    S.a_ready(cur);
    if constexpr (SP2) {
        PG8_STAGE(PG8_SB(0, 0), cB, voffB); PG8_STAGE(PG8_SB(0, 1), cB + hstep, voffB); PG8_STAGE(PG8_SA(0, 0), cA, voffA); PG8_STAGE(PG8_SA(0, 1), cA + hstep, voffA);
        if (wr == 1) PG8_BAR;
        PG8_WAIT_V(2); PG8_BAR;
        PG8_STAGE(PG8_SB(1, 0), cB + kstep, voffB); PG8_STAGE(PG8_SA(1, 0), cA + kstep, voffA); PG8_STAGE(PG8_SB(1, 1), cB + hstep + kstep, voffB);
        PG8_WAIT_V(6); PG8_BAR;
    } else {
        PG8_STAGE(PG8_SB(0, 0), cB, voffB); PG8_STAGE(PG8_SA(0, 0), cA, voffA); PG8_STAGE(PG8_SB(0, 1), cB + hstep, voffB); PG8_STAGE(PG8_SA(0, 1), cA + hstep, voffA);
        if (wr == 1) PG8_BAR;
        PG8_WAIT_V(4); PG8_BAR;
        PG8_STAGE(PG8_SB(1, 0), cB + kstep, voffB); PG8_STAGE(PG8_SA(1, 0), cA + kstep, voffA); PG8_STAGE(PG8_SB(1, 1), cB + hstep + kstep, voffB);
        PG8_WAIT_V(6); PG8_BAR;
    }
    for (;;) {
        const bool has_next = S.next(ui + 1, nxt);
        const char* nA = has_next ? (const char*)g.A + (size_t)nxt.pm * tstep : cA; const char* nB = has_next ? (const char*)g.Bt + (size_t)nxt.pn * tstep : cB;
        for (int t = 0; t < nt; t += 2) {
            const bool last = (t == nt - 2);
            if constexpr (Epi::MIDK) { if (t == (nt >> 1)) E.mid(acc, cur, ui, wr, wc, fr, fq); }
            const char* a1 = cA + (size_t)(t + 1) * kstep;
            const char* a2 = last ? nA : cA + (size_t)(t + 2) * kstep; const char* b2 = last ? nB : cB + (size_t)(t + 2) * kstep;
            const char* a3 = a2 + kstep; const char* b3 = b2 + kstep;
            if (last && has_next) S.a_ready(nxt);
            if constexpr (SP2) {
            PG8_LDB(B0, 0, 0); PG8_LDB(B1, 0, 1); PG8_SCHED; PG8_LDA(At, 0, 0); PG8_STAGE(PG8_SA(1, 1), a1 + hstep, voffA);
            PG8_WAIT_V(8); PG8_WAIT_L(0); PG8_BAR; PG8_MMA(0, 0, At, B0); PG8_MMA(0, 1, At, B1); PG8_BAR; PG8_SCHED;
            PG8_LDA(At, 0, 1); PG8_STAGE(PG8_SB(0, 0), b2, voffB); PG8_STAGE(PG8_SB(0, 1), b2 + hstep, voffB); PG8_STAGE(PG8_SA(0, 0), a2, voffA);
            PG8_WAIT_V(8); PG8_WAIT_L(0); PG8_BAR; PG8_MMA(1, 0, At, B0); PG8_MMA(1, 1, At, B1); PG8_BAR; PG8_SCHED;
            PG8_LDB(B0, 1, 0); PG8_LDB(B1, 1, 1); PG8_SCHED; PG8_LDA(At, 1, 0); PG8_STAGE(PG8_SA(0, 1), a2 + hstep, voffA);
            PG8_WAIT_V(8); PG8_WAIT_L(0); PG8_BAR; PG8_MMA(0, 0, At, B0); PG8_MMA(0, 1, At, B1); PG8_BAR; PG8_SCHED;
            PG8_LDA(At, 1, 1); PG8_STAGE(PG8_SB(1, 0), b3, voffB); PG8_STAGE(PG8_SB(1, 1), b3 + hstep, voffB); PG8_STAGE(PG8_SA(1, 0), a3, voffA);
            PG8_WAIT_V(8); PG8_WAIT_L(0); PG8_BAR; PG8_MMA(1, 0, At, B0); PG8_MMA(1, 1, At, B1); PG8_BAR; PG8_SCHED;
            } else {
            PG8_LDB(B0, 0, 0); PG8_SCHED; PG8_LDA(At, 0, 0); PG8_STAGE(PG8_SA(1, 1), a1 + hstep, voffA);
            PG8_WAIT_L(8); PG8_BAR; PG8_WAIT_L(0); PG8_MMA(0, 0, At, B0); PG8_BAR; PG8_SCHED;
            PG8_LDB(B1, 0, 1); PG8_STAGE(PG8_SB(0, 0), b2, voffB);
            PG8_BAR; PG8_WAIT_L(0); PG8_MMA(0, 1, At, B1); PG8_BAR;
            PG8_LDA(At, 0, 1); PG8_STAGE(PG8_SA(0, 0), a2, voffA);
            PG8_BAR; PG8_WAIT_L(0); PG8_MMA(1, 0, At, B0); PG8_BAR; PG8_SCHED;
            PG8_STAGE(PG8_SB(0, 1), b2 + hstep, voffB);
            PG8_WAIT_V(6); PG8_BAR; PG8_MMA(1, 1, At, B1); PG8_BAR;
            PG8_LDB(B0, 1, 0); PG8_SCHED; PG8_LDA(At, 1, 0); PG8_STAGE(PG8_SA(0, 1), a2 + hstep, voffA);
            PG8_WAIT_L(8); PG8_BAR; PG8_WAIT_L(0); PG8_MMA(0, 0, At, B0); PG8_BAR; PG8_SCHED;
            PG8_LDB(B1, 1, 1); PG8_STAGE(PG8_SB(1, 0), b3, voffB);
            PG8_BAR; PG8_WAIT_L(0); PG8_MMA(0, 1, At, B1); PG8_BAR;
            PG8_LDA(At, 1, 1); PG8_STAGE(PG8_SA(1, 0), a3, voffA);
            PG8_BAR; PG8_WAIT_L(0); PG8_MMA(1, 0, At, B0); PG8_BAR; PG8_SCHED;
            PG8_STAGE(PG8_SB(1, 1), b3 + hstep, voffB);
            PG8_WAIT_V(6); PG8_BAR; PG8_MMA(1, 1, At, B1); PG8_BAR;
            }
        }
        if constexpr (ALIGN_EPI) { if (wr == 0) PG8_BAR; }
        if constexpr (!Epi::AFTER_DRAIN) { E(acc, cur, ui, wr, wc, fr, fq); S.done(cur); }
        if (!has_next) break;
#pragma unroll
        for (int a = 0; a < 2; ++a)
#pragma unroll
            for (int b = 0; b < 2; ++b)
#pragma unroll
                for (int m = 0; m < 4; ++m)
#pragma unroll
                    for (int n = 0; n < 2; ++n) acc[a][b][m][n] = (f32x4){0.f, 0.f, 0.f, 0.f};
        cur = nxt; cA = nA; cB = nB; ++ui; E.begin(cur, ui);
        if constexpr (ALIGN_EPI) { if (wr == 1) PG8_BAR; }
    }
    PG8_WAIT_V(0);
    if constexpr (!ALIGN_EPI) { if (wr == 0) PG8_BAR; }
    PG8_BAR;
    if constexpr (Epi::AFTER_DRAIN) { E.fused(acc, cur, wr, wc, fr, fq, lds, wid, lane); S.done(cur); }
#undef PG8_SA
#undef PG8_SB
#undef PG8_STAGE
#undef PG8_LDA
#undef PG8_LDB
#undef PG8_MMA
#undef PG8_WAIT_V
#undef PG8_WAIT_L
#undef PG8_BAR
#undef PG8_SCHED
}
}
namespace att {
typedef unsigned short bf16;
using bf16x8 = __attribute__((ext_vector_type(8))) short;
using s16x4  = __attribute__((ext_vector_type(4))) short;
using f32x16 = __attribute__((ext_vector_type(16))) float;
using f32x4  = __attribute__((ext_vector_type(4))) float;
using u32x4  = __attribute__((ext_vector_type(4))) unsigned;
constexpr int NW = 8, QBLK = 32, KVBLK = 64;
constexpr int LDQ = 768, LDK = 768, LDV = 1024, LDA = 2048;
constexpr float SCALE = 0.10206207261596577f;
constexpr float THR = 8.f;
#ifndef ATT_SDEPTH
#define ATT_SDEPTH 2
#endif
constexpr int SDEPTH = ATT_SDEPTH;
constexpr int SHM_V = KVBLK * 128 * 2, SHM_K = KVBLK * 128 * 2, SHM_ATTN = 2 * SHM_V + 2 * SHM_K + NW * 64 * 4;
#define KSWZ(row, colB) ((row) * 256 + ((colB) ^ (((row) & 7) << 4)))
#define SBAR() __builtin_amdgcn_sched_barrier(0)
__device__ __forceinline__ int crow(int r, int hi) { return (r & 3) + 8 * (r >> 2) + 4 * hi; }
__device__ __forceinline__ unsigned cvtpk(float lo, float hi) { unsigned r; asm volatile("v_cvt_pk_bf16_f32 %0, %1, %2" : "=v"(r) : "v"(lo), "v"(hi)); return r; }
__device__ __forceinline__ float bf2f(bf16 v) { return __uint_as_float((unsigned)v << 16); }
__device__ __forceinline__ bf16 f2bf(float f) { return (bf16)(cvtpk(f, 0.f) & 0xffffu); }

__device__ __forceinline__ void partialSM(f32x16& p0, f32x16& p1, float& m_reg, float& mn, float& alpha) {
  constexpr float C = SCALE * 1.4426950408889634f;
  float pmax = p0[0]; for (int r = 1; r < 16; ++r) pmax = fmaxf(pmax, p0[r]); for (int r = 0; r < 16; ++r) pmax = fmaxf(pmax, p1[r]);
  { auto rr = __builtin_amdgcn_permlane32_swap(__float_as_uint(pmax), __float_as_uint(pmax), false, false);
    pmax = fmaxf(__uint_as_float(rr[0]), __uint_as_float(rr[1])); }
  if (__builtin_expect(__all(pmax - m_reg <= THR / SCALE), 1)) { mn = m_reg; alpha = 1.f; }
  else { mn = fmaxf(m_reg, pmax); alpha = __builtin_amdgcn_exp2f((m_reg - mn) * C); m_reg = mn; }
  float mnC = -mn * C;
  for (int r = 0; r < 16; ++r) p0[r] = fmaf(p0[r], C, mnC); for (int r = 0; r < 16; ++r) p1[r] = fmaf(p1[r], C, mnC);
  for (int r = 0; r < 16; ++r) p0[r] = __builtin_amdgcn_exp2f(p0[r]);
}
__device__ __forceinline__ void finishSM(f32x16& p0, f32x16& p1, float alpha, float& l_reg, bf16x8& pa0, bf16x8& pa1, bf16x8& pa2, bf16x8& pa3) {
  for (int r = 0; r < 16; ++r) p1[r] = __builtin_amdgcn_exp2f(p1[r]);
  float ps = 0; for (int r = 0; r < 16; ++r) ps += p0[r]; for (int r = 0; r < 16; ++r) ps += p1[r];
  { auto rr = __builtin_amdgcn_permlane32_swap(__float_as_uint(ps), __float_as_uint(ps), false, false);
    ps = __uint_as_float(rr[0]) + __uint_as_float(rr[1]); }
  l_reg = l_reg * alpha + ps;
#define PK4(P, BASE, OUT) do { unsigned a0 = cvtpk(P[BASE + 0], P[BASE + 1]), a1 = cvtpk(P[BASE + 2], P[BASE + 3]);   \
    unsigned b0 = cvtpk(P[BASE + 4], P[BASE + 5]), b1 = cvtpk(P[BASE + 6], P[BASE + 7]);                              \
    auto r0 = __builtin_amdgcn_permlane32_swap(a0, b0, false, false); auto r1 = __builtin_amdgcn_permlane32_swap(a1, b1, false, false); \
    u32x4 w = {r0[0], r1[0], r0[1], r1[1]}; OUT = *reinterpret_cast<bf16x8*>(&w); } while (0)
  PK4(p0, 0, pa0); PK4(p0, 8, pa1); PK4(p1, 0, pa2); PK4(p1, 8, pa3);
#undef PK4
}
__device__ __forceinline__ void qkt(f32x16& p0, f32x16& p1, const bf16* Ks, const bf16x8* qr, int r32, int hi) {
  p0 = f32x16{}; p1 = f32x16{};
#pragma unroll
  for (int d0 = 0; d0 < 6; ++d0) { int cb = (d0 * 16 + hi * 8) * 2;
    bf16x8 b0 = *reinterpret_cast<const bf16x8*>((const char*)Ks + KSWZ(r32, cb));
    bf16x8 b1 = *reinterpret_cast<const bf16x8*>((const char*)Ks + KSWZ(32 + r32, cb));
    p0 = __builtin_amdgcn_mfma_f32_32x32x16_bf16(b0, qr[d0], p0, 0, 0, 0);
    p1 = __builtin_amdgcn_mfma_f32_32x32x16_bf16(b1, qr[d0], p1, 0, 0, 0); }
}
__device__ __forceinline__ int v_st(int k, int c) { const int kk = (k & ~0xC) | ((k & 4) << 1) | ((k & 8) >> 1); return ((kk >> 3) * 4 + (c >> 5)) * 512 + ((kk & 7) * 32 + (c & 31)) * 2; }
__device__ __forceinline__ int v_rd_base(int lane) { return ((lane & 3) << 3) | (((lane >> 2) & 3) << 6) | (((lane >> 4) & 1) << 5) | (((lane >> 5) & 1) << 8); }
constexpr int v_rd_off(int d0, int ks, int half) { return d0 * 512 + ks * 4096 + half * 2048; }
template <int OFF> __device__ __forceinline__ s16x4 tr_read(int vb) {
  s16x4 r; asm volatile("ds_read_b64_tr_b16 %0, %1 offset:%2" : "=&v"(r) : "v"(vb), "i"(OFF) : "memory"); return r;
}
template <int D0> __device__ __forceinline__ void pv_one(f32x16& od, int vb, bf16x8 pa0, bf16x8 pa1, bf16x8 pa2, bf16x8 pa3) {
  const s16x4 l0 = tr_read<v_rd_off(D0, 0, 0)>(vb), h0 = tr_read<v_rd_off(D0, 0, 1)>(vb), l1 = tr_read<v_rd_off(D0, 1, 0)>(vb), h1 = tr_read<v_rd_off(D0, 1, 1)>(vb);
  const s16x4 l2 = tr_read<v_rd_off(D0, 2, 0)>(vb), h2 = tr_read<v_rd_off(D0, 2, 1)>(vb), l3 = tr_read<v_rd_off(D0, 3, 0)>(vb), h3 = tr_read<v_rd_off(D0, 3, 1)>(vb);
  asm volatile("s_waitcnt lgkmcnt(0)" ::: "memory"); SBAR();
#define PK(L, H) (bf16x8){L[0], L[1], L[2], L[3], H[0], H[1], H[2], H[3]}
  od = __builtin_amdgcn_mfma_f32_32x32x16_bf16(pa0, PK(l0, h0), od, 0, 0, 0);
  od = __builtin_amdgcn_mfma_f32_32x32x16_bf16(pa1, PK(l1, h1), od, 0, 0, 0);
  od = __builtin_amdgcn_mfma_f32_32x32x16_bf16(pa2, PK(l2, h2), od, 0, 0, 0);
  od = __builtin_amdgcn_mfma_f32_32x32x16_bf16(pa3, PK(l3, h3), od, 0, 0, 0);
#undef PK
}
__device__ __forceinline__ void pv_d0(f32x16* o, int vb, bf16x8 pa0, bf16x8 pa1, bf16x8 pa2, bf16x8 pa3) {
  pv_one<0>(o[0], vb, pa0, pa1, pa2, pa3); pv_one<1>(o[1], vb, pa0, pa1, pa2, pa3); pv_one<2>(o[2], vb, pa0, pa1, pa2, pa3); pv_one<3>(o[3], vb, pa0, pa1, pa2, pa3);
}

__device__ __forceinline__ void attn_unit(const bf16* __restrict__ Qb, const bf16* __restrict__ Kh, const bf16* __restrict__ Vh,
                                          bf16* Ab, float* ssq, int NT, char* lds, int dry = 0) {
  const int tid = threadIdx.x, wid = tid >> 6, lane = tid & 63, r32 = lane & 31, hi = lane >> 5;
  const int wlim = NT - 4 + (wid >> 1);
  bf16* V_lds = (bf16*)lds; bf16* K_lds = (bf16*)(lds + 2 * SHM_V);
  float* ws = (float*)(lds + 2 * SHM_V + 2 * SHM_K) + wid * 64; float* li_l = ws; float* al_l = ws + 32;
  float m_reg = -1e30f, l_reg = 0; f32x16 o[4] = {}; bf16x8 qr[6];
  const bf16* Qw = Qb + (long)(wid * QBLK + r32) * LDQ + hi * 8;
#pragma unroll
  for (int d0 = 0; d0 < 6; ++d0) qr[d0] = *reinterpret_cast<const bf16x8*>(Qw + d0 * 16);
  const int sr = tid >> 4, sc = (tid & 15) * 8, vst0 = v_st(sr, sc), vst1 = v_st(32 + sr, sc);
  const int sck = sc < 96 ? sc : sc - 32;
  const int vb0 = (int)(uintptr_t)V_lds + v_rd_base(lane);
  struct { bf16x8 vs0, vs1, ks0, ks1; } sr_[SDEPTH];
  const unsigned kofs = (unsigned)(sr * LDK + sck) * 2u, vofs = (unsigned)(sr * LDV + sc) * 2u;
#define SLOAD(i, k0) do { const char* kb_ = (const char*)Kh + (size_t)(k0) * (LDK * 2); const char* vb_ = (const char*)Vh + (size_t)(k0) * (LDV * 2); \
    sr_[i].vs0 = *(const bf16x8*)(vb_ + vofs); sr_[i].vs1 = *(const bf16x8*)(vb_ + 32 * LDV * 2 + vofs); \
    sr_[i].ks0 = *(const bf16x8*)(kb_ + kofs); sr_[i].ks1 = *(const bf16x8*)(kb_ + 32 * LDK * 2 + kofs); } while (0)
#define SWRITE(b, i) do { *(bf16x8*)((char*)V_lds + (b) * SHM_V + vst0) = sr_[i].vs0;          \
    *(bf16x8*)((char*)V_lds + (b) * SHM_V + vst1) = sr_[i].vs1; int kc = sc * 2;               \
    *(bf16x8*)((char*)K_lds + (b) * SHM_K + KSWZ(sr, kc)) = sr_[i].ks0;                       \
    *(bf16x8*)((char*)K_lds + (b) * SHM_K + KSWZ(32 + sr, kc)) = sr_[i].ks1; } while (0)
#define SWAIT() do { if constexpr (SDEPTH == 2) asm volatile("s_waitcnt vmcnt(4)" ::: "memory"); else asm volatile("s_waitcnt vmcnt(0)" ::: "memory"); } while (0)
#define RESC(a) do { if (__any((a) < 1.f)) { if (hi == 0) al_l[r32] = (a); asm volatile("s_waitcnt lgkmcnt(0)" ::: "memory"); \
    for (int d = 0; d < 4; ++d) for (int r = 0; r < 16; ++r) o[d][r] *= al_l[crow(r, hi)]; } } while (0)
#ifdef EXP_NOMASK
#define TMASK(P0,P1,t) do{}while(0)
#else
#define TMASK(P0, P1, t) do { if ((t) > wlim) { for (int r = 0; r < 16; ++r) { P0[r] = -1e30f; P1[r] = -1e30f; } } } while (0)
#endif
  f32x16 pA0, pA1, pB0, pB1; float mnA, mnB, alA, alB; bf16x8 pa0, pa1, pa2, pa3;
  constexpr int SE = 0, SO = SDEPTH - 1;
  SLOAD(SE, 0); asm volatile("s_waitcnt vmcnt(0)" ::: "memory"); SWRITE(0, SE); __syncthreads();
  qkt(pA0, pA1, K_lds, qr, r32, hi); partialSM(pA0, pA1, m_reg, mnA, alA);
  SLOAD(SO, KVBLK); if constexpr (SDEPTH == 2) { if (2 < NT) SLOAD(SE, 2 * KVBLK); }
  SWAIT(); SWRITE(1, SO); __syncthreads();
  for (int j = 1; j + 1 < NT; j += 2) {
    SBAR(); qkt(pB0, pB1, (bf16*)((char*)K_lds + SHM_K), qr, r32, hi);
    finishSM(pA0, pA1, alA, l_reg, pa0, pa1, pa2, pa3); SBAR();
    SLOAD(SO, (j + SDEPTH) * KVBLK); SBAR();
    pv_d0(o, vb0, pa0, pa1, pa2, pa3); TMASK(pB0, pB1, j); partialSM(pB0, pB1, m_reg, mnB, alB);
    __syncthreads(); SWAIT(); SWRITE(0, SE);
    RESC(alB); __syncthreads();
    SBAR(); qkt(pA0, pA1, K_lds, qr, r32, hi);
    finishSM(pB0, pB1, alB, l_reg, pa0, pa1, pa2, pa3); SBAR();
    if (SDEPTH == 1 || j + 3 < NT) SLOAD(SE, (j + 1 + SDEPTH) * KVBLK); SBAR();
    pv_d0(o, vb0 + (int)SHM_V, pa0, pa1, pa2, pa3); TMASK(pA0, pA1, j + 1); partialSM(pA0, pA1, m_reg, mnA, alA);
    __syncthreads(); SWAIT(); SWRITE(1, SO);
    RESC(alA); __syncthreads();
  }
  SBAR(); qkt(pB0, pB1, (bf16*)((char*)K_lds + SHM_K), qr, r32, hi);
  finishSM(pA0, pA1, alA, l_reg, pa0, pa1, pa2, pa3); SBAR();
  pv_d0(o, vb0, pa0, pa1, pa2, pa3); TMASK(pB0, pB1, NT - 1); partialSM(pB0, pB1, m_reg, mnB, alB);
  __syncthreads(); RESC(alB);
  finishSM(pB0, pB1, alB, l_reg, pa0, pa1, pa2, pa3); SBAR();
  pv_d0(o, vb0 + (int)SHM_V, pa0, pa1, pa2, pa3);
  if (hi == 0) li_l[r32] = l_reg; asm volatile("s_waitcnt lgkmcnt(0)" ::: "memory");
  bf16* stg = (bf16*)(lds + SHM_ATTN + wid * 8704);
  {
    bf16* sp = stg + (4 * hi) * 136 + r32;
#pragma unroll
    for (int r = 0; r < 16; ++r) {
      const float rl = __builtin_amdgcn_rcpf(li_l[crow(r, hi)]);
#pragma unroll
      for (int d0 = 0; d0 < 4; ++d0) sp[((r & 3) + 8 * (r >> 2)) * 136 + d0 * 32] = f2bf(o[d0][r] * rl);
    }
  }
  asm volatile("s_waitcnt lgkmcnt(0)" ::: "memory");
  {
    const int rr = lane >> 4, ch = lane & 15;
    bf16* Aw = Ab + (long)(wid * QBLK + rr) * LDA + ch * 8; float* sw = ssq + (long)(wid * QBLK + rr) * 8;
#pragma unroll
    for (int i = 0; i < 8; ++i) {
      const u32x4 ov = *(const u32x4*)(stg + (i * 4 + rr) * 136 + ch * 8);
      bf16* gp = Aw + (long)(i * 4) * LDA; const u32x4 gv = *(const u32x4*)gp;
      float ss = 0.f; u32x4 w;
#pragma unroll
      for (int k = 0; k < 4; ++k) {
        const float a = __uint_as_float(ov[k] << 16), b = __uint_as_float(ov[k] & 0xffff0000u);
        const float ga = __uint_as_float(gv[k] << 16), gb = __uint_as_float(gv[k] & 0xffff0000u);
        ss += a * a + b * b; w[k] = cvtpk(a * ga, b * gb);
      }
      if (!dry) *(u32x4*)gp = w;
      ss += __shfl_xor(ss, 1); ss += __shfl_xor(ss, 2); ss += __shfl_xor(ss, 4); ss += __shfl_xor(ss, 8);
      if (ch == 0 && !dry) sw[(long)(i * 4) * 8] = ss;
    }
  }
  asm volatile("s_waitcnt lgkmcnt(0)" ::: "memory");
#undef SLOAD
#undef SWRITE
#undef SWAIT
#undef RESC
#undef TMASK
}

constexpr int GST = 132;
__device__ __forceinline__ void gmlp_unit(int R0, const bf16* __restrict__ Vg, const bf16* __restrict__ Ug, const bf16* __restrict__ WSP, const float* __restrict__ bsp,
                                          const float* __restrict__ lng, const float* __restrict__ lnb, const float* __restrict__ lnmu, const float* __restrict__ lnrs,
                                          bf16* A, float* ssq, char* lds, int dry = 0) {
  const int tid = threadIdx.x, wid = tid >> 6, lane = tid & 63, r32 = lane & 31, hi = lane >> 5;
  char* Vt = lds;
  float* stg = (float*)(lds + 2 * SHM_V);
  const int sr = tid >> 4, sc = (tid & 15) * 8;
  const int tb = wid & 3, dh = wid >> 2;
  const int vb0 = (int)(uintptr_t)Vt + v_rd_base(lane);
  float mu[4], rs[4], ss[4];
#pragma unroll
  for (int q = 0; q < 4; ++q) { mu[q] = lnmu[R0 + q * 32 + sr]; rs[q] = lnrs[R0 + q * 32 + sr]; ss[q] = 0.f; }
  const char* vbase = (const char*)(Vg + (size_t)R0 * 1024); const char* ubase = (const char*)(Ug + (size_t)R0 * 1024); char* abase = (char*)(A + (size_t)R0 * LDA + 1024);
  const unsigned vofs = (unsigned)(sr * 1024 + sc) * 2u, aofs = (unsigned)(sr * LDA + sc) * 2u;
  const bf16* wbase = WSP + (size_t)(tb * 32 + r32) * 128 + 8 * hi;
  const int ntile = (tb >= 2) ? 2 : 1;
  bf16x8 vreg[4], ureg[4], greg[4], wf[2][4];
#define GLOADV(g) do { _Pragma("unroll") for (int q = 0; q < 4; ++q) vreg[q] = *(const bf16x8*)(vbase + (size_t)(q * 32) * 2048 + (g) * 256 + vofs); } while (0)
#define GLOADU(g) do { _Pragma("unroll") for (int q = 0; q < 4; ++q) { ureg[q] = *(const bf16x8*)(ubase + (size_t)(q * 32) * 2048 + (g) * 256 + vofs); \
      greg[q] = *(const bf16x8*)(abase + (size_t)(q * 32) * (LDA * 2) + (g) * 256 + aofs); } \
    _Pragma("unroll") for (int t_ = 0; t_ < 2; ++t_) _Pragma("unroll") for (int k_ = 0; k_ < 4; ++k_) wf[t_][k_] = *(const bf16x8*)(wbase + (size_t)(g) * 16384 + t_ * 64 + k_ * 16); } while (0)
  GLOADV(0); GLOADU(0);
  for (int g = 0; g < 8; ++g) {
    { const f32x4 g0 = *(const f32x4*)(lng + g * 128 + sc), g1 = *(const f32x4*)(lng + g * 128 + sc + 4), b0 = *(const f32x4*)(lnb + g * 128 + sc), b1 = *(const f32x4*)(lnb + g * 128 + sc + 4);
#pragma unroll
      for (int q = 0; q < 4; ++q) {
        const int s = q * 32 + sr; const bf16x8 a = vreg[q]; const float m_ = mu[q], r_ = rs[q];
        float y[8];
#pragma unroll
        for (int k = 0; k < 4; ++k) { y[k] = (bf2f((bf16)a[k]) - m_) * r_ * g0[k] + b0[k]; y[4 + k] = (bf2f((bf16)a[4 + k]) - m_) * r_ * g1[k] + b1[k]; }
        u32x4 w = {cvtpk(y[0], y[1]), cvtpk(y[2], y[3]), cvtpk(y[4], y[5]), cvtpk(y[6], y[7])};
        *(u32x4*)(Vt + (s >> 6) * SHM_V + v_st(s & 63, sc)) = w;
      } }
    if (g < 7) GLOADV(g + 1);
    __syncthreads();
    f32x16 o[2] = {};
    for (int tile = 0; tile < ntile; ++tile) {
      const int vb = vb0 + tile * SHM_V;
      if (dh == 0) { pv_one<0>(o[0], vb, wf[tile][0], wf[tile][1], wf[tile][2], wf[tile][3]); pv_one<1>(o[1], vb, wf[tile][0], wf[tile][1], wf[tile][2], wf[tile][3]); }
      else         { pv_one<2>(o[0], vb, wf[tile][0], wf[tile][1], wf[tile][2], wf[tile][3]); pv_one<3>(o[1], vb, wf[tile][0], wf[tile][1], wf[tile][2], wf[tile][3]); }
    }
    { float* sp = stg + (tb * 32 + 4 * hi) * GST + dh * 64 + r32; const float* bp = bsp + g * 128 + tb * 32 + 4 * hi;
#pragma unroll
      for (int r = 0; r < 16; ++r) { const int tr = (r & 3) + 8 * (r >> 2); const float bias = bp[tr]; sp[tr * GST] = o[0][r] + bias; sp[tr * GST + 32] = o[1][r] + bias; } }
    __syncthreads();
#pragma unroll
    for (int q = 0; q < 4; ++q) {
      const float* mp = stg + (q * 32 + sr) * GST + sc; const f32x4 m0 = *(const f32x4*)mp, m1 = *(const f32x4*)(mp + 4);
      const bf16x8 uu = ureg[q], gg = greg[q]; float res[8];
#pragma unroll
      for (int k = 0; k < 4; ++k) { res[k] = bf2f((bf16)uu[k]) * m0[k]; res[4 + k] = bf2f((bf16)uu[4 + k]) * m1[k]; }
#pragma unroll
      for (int k = 0; k < 8; ++k) ss[q] += res[k] * res[k];
      u32x4 w = {cvtpk(res[0] * bf2f((bf16)gg[0]), res[1] * bf2f((bf16)gg[1])), cvtpk(res[2] * bf2f((bf16)gg[2]), res[3] * bf2f((bf16)gg[3])),
                 cvtpk(res[4] * bf2f((bf16)gg[4]), res[5] * bf2f((bf16)gg[5])), cvtpk(res[6] * bf2f((bf16)gg[6]), res[7] * bf2f((bf16)gg[7]))};
      if (!dry) *(u32x4*)(abase + (size_t)(q * 32) * (LDA * 2) + g * 256 + aofs) = w;
    }
    if (g < 7) GLOADU(g + 1);
  }
#pragma unroll
  for (int q = 0; q < 4; ++q) {
    float v = ss[q]; v += __shfl_xor(v, 1); v += __shfl_xor(v, 2); v += __shfl_xor(v, 4); v += __shfl_xor(v, 8);
    if ((tid & 15) == 0 && !dry) { ssq[(size_t)(R0 + q * 32 + sr) * 2] = v; ssq[(size_t)(R0 + q * 32 + sr) * 2 + 1] = 0.f; }
  }
  __syncthreads();
#undef GLOADV
#undef GLOADU
}
#undef KSWZ
#undef SBAR
}
namespace cg = cooperative_groups;
#define LAS __attribute__((address_space(3)))
typedef unsigned short bf16;
typedef unsigned v4u __attribute__((ext_vector_type(4)));
typedef float f32x4 __attribute__((ext_vector_type(4)));
constexpr int NWAVES = 8;
constexpr int BATCH = 4, SEQ = 8192, DM = 1024, M = BATCH * SEQ;
constexpr int NPAD = 4864;
constexpr float EPS = 1e-6f;
constexpr size_t MiB = 1u << 20;
constexpr size_t WS_WIN = 0, WS_WUQ = 10 * MiB, WS_WUKV = 11 * MiB, WS_WOUT = 12 * MiB, WS_WSP = 16 * MiB, WS_ROPE = 17 * MiB;
constexpr size_t WS_RSX = 18 * MiB, WS_RSQ = WS_RSX + 128 * 1024, WS_RSKV = WS_RSQ + 128 * 1024;
constexpr size_t WS_LNMU = WS_RSKV + 128 * 1024, WS_LNRS = WS_LNMU + 128 * 1024;
constexpr size_t WS_SSQM = 19 * MiB, WS_SSQG = 20 * MiB, WS_HSQ = 21 * MiB;
constexpr size_t WS_XB = 32 * MiB, WS_Q = 32 * MiB;
constexpr size_t WS_QLAT = 96 * MiB, WS_KVLAT = 120 * MiB, WS_U = 136 * MiB, WS_V = 200 * MiB, WS_AMIX = 264 * MiB, WS_K = 392 * MiB, WS_VV = 440 * MiB, WS_END = 504 * MiB;
constexpr int RING_BYTES = 131072, TAB_OFF = RING_BYTES, LDS_BYTES = 147456;

__constant__ float INVF[16] = {1.0f, 0.5623413251903491f, 0.31622776601683794f, 0.1778279410038923f, 0.1f, 0.05623413251903491f, 0.03162277660168379f, 0.01778279410038923f,
                               0.01f, 0.005623413251903491f, 0.003162277660168379f, 0.001778279410038923f, 0.001f, 0.0005623413251903491f, 0.00031622776601683794f, 0.0001778279410038923f};

#define LDS_WAIT() asm volatile("s_waitcnt lgkmcnt(0)" ::: "memory")
__device__ __forceinline__ unsigned pk2(float lo, float hi) { return pg8::cvt_pk_bf16(lo, hi); }
__device__ __forceinline__ float wave_sum(float v) {
#pragma unroll
    for (int o = 1; o < 64; o <<= 1) v += __shfl_xor(v, o);
    return v;
}
__device__ __forceinline__ void transpose_item(const float* W, int N, int K, bf16* WT, int dst_row, int k0, int n0, const float* g1, const float* g2, int ksplit, LAS float* scr, int lane) {
#pragma unroll 8
    for (int i = 0; i < 32; ++i) { const int kk = 2 * i + (lane >> 5), k = k0 + kk; const float gk = (k < ksplit) ? g1[k] : g2[k - ksplit];
        scr[kk * 33 + (lane & 31)] = W[(size_t)k * N + n0 + (lane & 31)] * gk; }
    LDS_WAIT(); asm volatile("" ::: "memory");
    const int c = lane & 7;
#pragma unroll
    for (int j = 0; j < 4; ++j) { const int n = (lane >> 3) + 8 * j; const LAS float* s = scr + (8 * c) * 33 + n;
        v4u o; o.x = pk2(s[0 * 33], s[1 * 33]); o.y = pk2(s[2 * 33], s[3 * 33]); o.z = pk2(s[4 * 33], s[5 * 33]); o.w = pk2(s[6 * 33], s[7 * 33]);
        *(v4u*)(WT + (size_t)(dst_row + n) * K + k0 + 8 * c) = o; }
    LDS_WAIT(); asm volatile("" ::: "memory");
}

struct Args { const float* in[15]; float* out; unsigned char* ws; int ph_lo, ph_hi, dry, pad; };

__global__ void __launch_bounds__(NWAVES * 64, 2) fwd_kernel(Args args) {
    extern __shared__ __attribute__((aligned(16))) unsigned char lds[];
    LAS unsigned char* ldsl = (LAS unsigned char*)lds;
    const int tid = threadIdx.x, lane = tid & 63, wave = __builtin_amdgcn_readfirstlane(tid >> 6);
    const int G = gridDim.x, bx = blockIdx.x;
    const int vcu = (G % 8 == 0) ? (bx % 8) * (G / 8) + bx / 8 : bx;
    const int gw = vcu * NWAVES + wave, NGW = G * NWAVES;
    unsigned char* ws = args.ws;
    const float* x = args.in[0]; const float* norm_in_g = args.in[1]; const float* w_in = args.in[2]; const float* q_norm_g = args.in[3]; const float* w_uq = args.in[4];
    const float* kv_norm_g = args.in[5]; const float* w_ukv = args.in[6]; const float* ln_g = args.in[7]; const float* ln_b = args.in[8]; const float* w_sp = args.in[9];
    const float* b_sp = args.in[10]; const float* on_mla_g = args.in[11]; const float* on_gmlp_g = args.in[12]; const float* w_out = args.in[13]; const float* fin_g = args.in[14];
    bf16* WIN = (bf16*)(ws + WS_WIN); bf16* WUQ = (bf16*)(ws + WS_WUQ); bf16* WUKV = (bf16*)(ws + WS_WUKV); bf16* WOUT = (bf16*)(ws + WS_WOUT); bf16* WSP = (bf16*)(ws + WS_WSP);
    float* ROPE = (float*)(ws + WS_ROPE); float* RSX = (float*)(ws + WS_RSX); float* RSQ = (float*)(ws + WS_RSQ); float* RSKV = (float*)(ws + WS_RSKV);
    float* LNMU = (float*)(ws + WS_LNMU); float* LNRS = (float*)(ws + WS_LNRS);
    float* SSQM = (float*)(ws + WS_SSQM); float* SSQG = (float*)(ws + WS_SSQG); float* HSQ = (float*)(ws + WS_HSQ);
    bf16* XB = (bf16*)(ws + WS_XB); bf16* QB_ = (bf16*)(ws + WS_Q); bf16* QLAT = (bf16*)(ws + WS_QLAT); bf16* KVLAT = (bf16*)(ws + WS_KVLAT);
    bf16* UB = (bf16*)(ws + WS_U); bf16* VB = (bf16*)(ws + WS_V); bf16* AMIX = (bf16*)(ws + WS_AMIX); bf16* KB = (bf16*)(ws + WS_K); bf16* VV = (bf16*)(ws + WS_VV);
    const int lo = args.ph_lo, hi = args.ph_hi, dry = args.dry;
#ifndef PROBE_REP
#define PROBE_REP 0
#endif
#ifndef PHASE_MASK
#define PHASE_MASK 0x7f
#endif
#define IN(k) (lo <= (k) && (k) < hi)
#define SEAM(k) do { if (IN(k) && IN((k) + 1)) { cg::this_grid().sync(); } } while (0)

    if (((PHASE_MASK >> 0) & 1) && IN(0)) {
        LAS float* scr = (LAS float*)(ldsl + wave * 16384);
        constexpr int I_IN = 16 * 149, I_UQ = 6 * 24, I_UKV = 4 * 48, I_OUT = 32 * 32, NITEMS = I_IN + I_UQ + I_UKV + I_OUT;
        for (int it = gw; it < NITEMS; it += NGW) {
            int r = it;
            if (r < I_IN) { const int kb = r / 149, nb = r % 149, n0 = nb * 32; transpose_item(w_in, 4768, 1024, WIN, n0 + (n0 >= 672 ? 96 : 0), kb * 64, n0, norm_in_g, norm_in_g, 1 << 30, scr, lane); continue; } r -= I_IN;
            if (r < I_UQ) { const int kb = r / 24, nb = r % 24; transpose_item(w_uq, 768, 384, WUQ, nb * 32, kb * 64, nb * 32, q_norm_g, q_norm_g, 1 << 30, scr, lane); continue; } r -= I_UQ;
            if (r < I_UKV) { const int kb = r / 48, nb = r % 48; transpose_item(w_ukv, 1536, 256, WUKV, nb * 32, kb * 64, nb * 32, kv_norm_g, kv_norm_g, 1 << 30, scr, lane); continue; } r -= I_UKV;
            { const int kb = r / 32, nb = r % 32; transpose_item(w_out, 1024, 2048, WOUT, nb * 32, kb * 64, nb * 32, on_mla_g, on_gmlp_g, 1024, scr, lane); }
        }
        const int gt = vcu * (NWAVES * 64) + tid, NGT = G * NWAVES * 64;
        for (int i = gt; i < 96 * 1024 / 8; i += NGT) *(v4u*)(WIN + (size_t)672 * 1024 + (size_t)i * 8) = (v4u){0u, 0u, 0u, 0u};
        for (int i = gt; i < 8 * 128 * 128 / 8; i += NGT) {
            const int e = i * 8, s0 = e & 127, t = (e >> 7) & 127; const bool keep = (s0 >> 6) <= (t >> 6);
            const f32x4 a = *(const f32x4*)(w_sp + e), b = *(const f32x4*)(w_sp + e + 4);
            v4u o = {pk2(a[0], a[1]), pk2(a[2], a[3]), pk2(b[0], b[1]), pk2(b[2], b[3])}; if (!keep) o = (v4u){0u, 0u, 0u, 0u};
            *(v4u*)(WSP + e) = o;
        }
        for (int i = gt; i < SEQ * 16; i += NGT) {
            const int pos = i >> 4, fi = i & 15; const float ang = (float)pos * INVF[fi];
            const double rev = (double)ang * 0.15915494309189535; const float fr = (float)(rev - floor(rev));
            ROPE[2 * i] = __builtin_amdgcn_cosf(fr); ROPE[2 * i + 1] = __builtin_amdgcn_sinf(fr);
        }
        for (int m = gw; m < M; m += NGW) {
            const f32x4* xr = (const f32x4*)(x + (size_t)m * DM) + lane; f32x4 v[4]; float s = 0.f;
#pragma unroll
            for (int j = 0; j < 4; ++j) { v[j] = xr[64 * j]; s += (v[j][0] * v[j][0] + v[j][1] * v[j][1]) + (v[j][2] * v[j][2] + v[j][3] * v[j][3]); }
            s = wave_sum(s);
            unsigned long long* o8 = (unsigned long long*)(XB + (size_t)m * DM) + lane;
#pragma unroll
            for (int j = 0; j < 4; ++j) o8[64 * j] = (unsigned long long)pk2(v[j][0], v[j][1]) | ((unsigned long long)pk2(v[j][2], v[j][3]) << 32);
            if (lane == 0) RSX[m] = __builtin_amdgcn_rsqf(s * (1.0f / DM) + EPS);
        }
        __syncthreads();
    }
    SEAM(0);
    if (((PHASE_MASK >> 1) & 1) && IN(1)) {
        pg8::Gemm g{XB, WIN, M, NPAD, DM}; pg8::StaticOrder S; S.init(M, NPAD, G, bx);
        pg8::EpiProj E{RSX, QLAT, KVLAT, KB, AMIX, UB, VB, ROPE};
        pg8::gemm_phase<pg8::EpiProj, pg8::StaticOrder, true, true>(ldsl, g, S, E);
    }
    SEAM(1);
    if (((PHASE_MASK >> 2) & 1) && IN(2)) {
        for (int m = gw; m < M; m += NGW) {
            const unsigned* pq = (const unsigned*)(QLAT + (size_t)m * 384) + lane * 3; float s = 0.f;
#pragma unroll
            for (int j = 0; j < 3; ++j) { const unsigned w = pq[j]; const float a = __uint_as_float(w << 16), b = __uint_as_float(w & 0xffff0000u); s += a * a + b * b; }
            const unsigned* pk = (const unsigned*)(KVLAT + (size_t)m * 256) + lane * 2; float s2 = 0.f;
#pragma unroll
            for (int j = 0; j < 2; ++j) { const unsigned w = pk[j]; const float a = __uint_as_float(w << 16), b = __uint_as_float(w & 0xffff0000u); s2 += a * a + b * b; }
            s = wave_sum(s); s2 = wave_sum(s2);
            if (lane == 0) { RSQ[m] = __builtin_amdgcn_rsqf(s * (1.0f / 384.0f) + EPS); RSKV[m] = __builtin_amdgcn_rsqf(s2 * (1.0f / 256.0f) + EPS); }
            const att::bf16x8 va = *(const att::bf16x8*)(VB + (size_t)m * 1024 + lane * 8), vb = *(const att::bf16x8*)(VB + (size_t)m * 1024 + 512 + lane * 8);
            float xv[16]; float sum = 0.f;
#pragma unroll
            for (int k = 0; k < 8; ++k) { xv[k] = att::bf2f((bf16)va[k]); xv[8 + k] = att::bf2f((bf16)vb[k]); }
#pragma unroll
            for (int k = 0; k < 16; ++k) sum += xv[k];
            const float mean = wave_sum(sum) * (1.0f / 1024.0f); float qd = 0.f;
#pragma unroll
            for (int k = 0; k < 16; ++k) { const float d = xv[k] - mean; qd += d * d; }
            qd = wave_sum(qd);
            if (lane == 0) { LNMU[m] = mean; LNRS[m] = __builtin_amdgcn_rsqf(qd * (1.0f / 1024.0f) + EPS); }
        }
    }
    SEAM(2);
    if (((PHASE_MASK >> 3) & 1) && IN(3)) {
#ifndef EXP_NOQ
        { int kq = 384; asm volatile("" : "+s"(kq)); pg8::Gemm g{QLAT, WUQ, M, 768, kq}; pg8::StaticOrder S; S.init(M, 768, G, bx); pg8::EpiQ E{RSQ, QB_, ROPE};
          pg8::gemm_phase<pg8::EpiQ, pg8::StaticOrder, true, true>(ldsl, g, S, E); }
#endif
#ifndef EXP_NOKV
        { int kk = 256; asm volatile("" : "+s"(kk)); pg8::Gemm g{KVLAT, WUKV, M, 1536, kk}; pg8::StaticOrder S; S.init(M, 1536, G, bx); pg8::EpiKV E{RSKV, KB, VV};
          pg8::gemm_phase<pg8::EpiKV, pg8::StaticOrder, true, true>(ldsl, g, S, E); }
#endif
#ifndef EXP_NOGMLP
        __syncthreads();
        for (int un = vcu; un < M / 128; un += G)
            att::gmlp_unit(un * 128, VB, UB, WSP, b_sp, ln_g, ln_b, LNMU, LNRS, AMIX, SSQG, (char*)lds, dry);
#endif
    }
    SEAM(3);
    if (((PHASE_MASK >> 4) & 1) && IN(4)) {
        for (int un = vcu; un < 1024; un += G) {
            const int v = un & 255, i = un >> 8, s = v & 7, bh = v >> 3; const int qb = (i == 0) ? s : (i == 1) ? 15 - s : (i == 2) ? 16 + s : 31 - s;
            const int b = bh >> 3, h = bh & 7; const size_t r0 = (size_t)b * SEQ, q0 = r0 + (size_t)qb * 256;
            att::attn_unit(QB_ + q0 * 768 + h * 96, KB + r0 * 768 + h * 96, VV + r0 * 1024 + h * 128, AMIX + q0 * 2048 + h * 128, SSQM + q0 * 8 + h, 4 * qb + 4, (char*)lds, dry);
            __syncthreads();
        }
    }
    SEAM(4);
    if (((PHASE_MASK >> 5) & 1) && IN(5)) {
        pg8::Gemm g{AMIX, WOUT, M, DM, 2048}; pg8::StaticOrder S; S.init(M, DM, G, bx);
        pg8::EpiOut E{x, args.out, SSQM, SSQG, HSQ, (LAS float*)(ldsl + TAB_OFF)};
        pg8::gemm_phase<pg8::EpiOut, pg8::StaticOrder, true, true>(ldsl, g, S, E);
    }
    SEAM(5);
    if (((PHASE_MASK >> 6) & 1) && IN(6)) {
        for (int m = gw; m < M; m += NGW) {
            float s = (lane < 16) ? HSQ[(size_t)m * 16 + lane] : 0.f; s = wave_sum(s);
            const float rstd = __builtin_amdgcn_rsqf(s * (1.0f / DM) + EPS);
            f32x4* orow = (f32x4*)(args.out + (size_t)m * DM) + lane; const f32x4* gp = (const f32x4*)fin_g + lane;
#pragma unroll
            for (int j = 0; j < 4; ++j) orow[64 * j] = orow[64 * j] * rstd * gp[64 * j];
        }
    }
#undef IN
#undef SEAM
}

#ifndef N_LAUNCHES
#define N_LAUNCHES 1
#endif
extern "C" void kernel_launch(void* const* d_in, const int* in_sizes, int n_in, void* d_out, int out_size, void* d_ws, size_t ws_size, hipStream_t stream) {
    static int grid = 0;
    if (grid == 0) {
        if (n_in != 15 || out_size != M * DM || ws_size < WS_END) { fprintf(stderr, "kernel_launch: unexpected shapes (n_in %d out %d ws %zu)\n", n_in, out_size, ws_size); grid = -1; return; }
        int dev = 0, cus = 0, per_cu = 0;
        hipGetDevice(&dev); hipDeviceGetAttribute(&cus, hipDeviceAttributeMultiprocessorCount, dev);
        if (hipFuncSetAttribute((const void*)fwd_kernel, hipFuncAttributeMaxDynamicSharedMemorySize, LDS_BYTES) != hipSuccess) { fprintf(stderr, "kernel_launch: hipFuncSetAttribute failed\n"); grid = -1; return; }
        if (hipOccupancyMaxActiveBlocksPerMultiprocessor(&per_cu, (const void*)fwd_kernel, NWAVES * 64, LDS_BYTES) != hipSuccess || per_cu < 1) { fprintf(stderr, "kernel_launch: occupancy query says %d\n", per_cu); per_cu = 1; }
        (void)hipGetLastError();
        grid = cus * (per_cu > 1 ? 1 : per_cu);
        if (grid % 8 != 0 || grid <= 0) { fprintf(stderr, "kernel_launch: odd grid %d\n", grid); }
    }
    if (grid < 0) return;
    Args a{};
    for (int i = 0; i < 15; ++i) a.in[i] = (const float*)d_in[i];
    a.out = (float*)d_out; a.ws = (unsigned char*)d_ws;
    if (N_LAUNCHES == 1) {
        a.ph_lo = 0; a.ph_hi = 7; void* kargs[] = {&a};
        hipError_t e = hipLaunchCooperativeKernel((const void*)fwd_kernel, dim3(grid), dim3(NWAVES * 64), kargs, LDS_BYTES, stream);
        if (e != hipSuccess) fprintf(stderr, "cooperative launch failed: %s (grid %d)\n", hipGetErrorString(e), grid);
    } else {
        for (int p = 0; p < 7; ++p) {
#ifdef PROBE_EXTRA
            if (p == PROBE_EXTRA) { a.ph_lo = p; a.ph_hi = p + 1; a.dry = 1; hipLaunchKernelGGL(fwd_kernel, dim3(grid), dim3(NWAVES * 64), LDS_BYTES, stream, a); a.dry = 0; }
#endif
            a.ph_lo = p; a.ph_hi = p + 1; hipLaunchKernelGGL(fwd_kernel, dim3(grid), dim3(NWAVES * 64), LDS_BYTES, stream, a); }
    }
}
```
